# Optimizing an MI355X kernel written in HIP

```python
import jax, jax.numpy as jnp
from jax import lax
import numpy as np

D_MODEL = 1024
BATCH = 16
SEQ = 4096
DEPTH = 4

CTX_LEN = 256
GRID_W = 64
HEAD_DIM = 64
D_CONV = 256
CONV_WIDTH = 31
N_DN_HEADS = 6
D_DN = N_DN_HEADS * HEAD_DIM
SHORT_CONV = 5
DN_CHUNK = 64
N_Q_HEADS = 6
N_KV_HEADS = 2
D_ATTN = N_Q_HEADS * HEAD_DIM
D_KV = N_KV_HEADS * HEAD_DIM
WINDOW = 128
ATTN_BLOCK = 128
ROPE_BASE = 10000.0
D_MIX = D_CONV + D_DN + D_ATTN
N_IN = 3 * D_CONV + 4 * D_DN + 4 * N_DN_HEADS + 2 * D_ATTN + 2 * D_KV
EPS = 1e-6

kernel_name = "hymba_style_conv_deltanet_swa_dit"


def _rmsnorm(x, w):
    xf = x.astype(jnp.float32)
    y = xf * lax.rsqrt(jnp.mean(xf * xf, axis=-1, keepdims=True) + EPS)
    return (y * w.astype(jnp.float32)).astype(x.dtype)


def _layernorm(x, w, b):
    xf = x.astype(jnp.float32)
    mu = jnp.mean(xf, axis=-1, keepdims=True)
    var = jnp.mean(jnp.square(xf - mu), axis=-1, keepdims=True)
    y = (xf - mu) * lax.rsqrt(var + EPS) * w.astype(jnp.float32) + b.astype(jnp.float32)
    return y.astype(x.dtype)


def _l2norm(x):
    return x * lax.rsqrt(jnp.sum(x * x, axis=-1, keepdims=True) + EPS)


def _depthwise_conv(x, w):
    k = w.shape[0]
    pad = (k - 1) // 2
    return lax.conv_general_dilated(
        x, w[:, None, :].astype(x.dtype), window_strides=(1,), padding=[(pad, k - 1 - pad)],
        dimension_numbers=('NWC', 'WIO', 'NWC'), feature_group_count=x.shape[-1])


def _ada(cond, w, b):
    m = jax.nn.silu(cond) @ w + b
    return jnp.split(m, 3, axis=-1)


def _split_cols(p):
    sizes = (D_CONV, D_CONV, D_CONV,
             D_DN, D_DN, D_DN, D_DN,
             4 * N_DN_HEADS,
             D_ATTN, D_KV, D_KV, D_ATTN)
    idx = np.cumsum(sizes)[:-1].tolist()
    return jnp.split(p, idx, axis=-1)


def _axial_rope(t, rows, cols):
    d = t.shape[-1]
    half, quarter = d // 2, d // 4
    inv = ROPE_BASE ** (-jnp.arange(quarter, dtype=jnp.float32) / quarter)

    def rot(th, pos):
        ang = pos.astype(jnp.float32)[:, None] * inv
        cos = jnp.cos(ang)[None, :, None, :].astype(t.dtype)
        sin = jnp.sin(ang)[None, :, None, :].astype(t.dtype)
        x1, x2 = th[..., :quarter], th[..., quarter:]
        return jnp.concatenate([x1 * cos - x2 * sin, x2 * cos + x1 * sin], axis=-1)

    return jnp.concatenate([rot(t[..., :half], rows), rot(t[..., half:], cols)], axis=-1)


def _conformer_conv(a_val, a_gate, z, conv_w, conv_b, ln_w, ln_b):
    u = a_val * jax.nn.sigmoid(a_gate)
    u = _depthwise_conv(u, conv_w) + conv_b
    u = jax.nn.silu(_layernorm(u, ln_w, ln_b))
    return u * jax.nn.silu(z)


def _gdn_inputs(q, k, v, sc, conv_w, a_log, dt_bias):
    b_, l_ = q.shape[:2]
    qkv = jax.nn.silu(_depthwise_conv(jnp.concatenate([q, k, v], axis=-1), conv_w)).astype(jnp.float32)
    q, k, v = jnp.split(qkv, 3, axis=-1)
    q = _l2norm(q.reshape(b_, l_, N_DN_HEADS, HEAD_DIM))
    k = _l2norm(k.reshape(b_, l_, N_DN_HEADS, HEAD_DIM))
    v = v.reshape(b_, l_, N_DN_HEADS, HEAD_DIM)
    sc = sc.astype(jnp.float32).reshape(b_, l_, 2, 2, N_DN_HEADS)
    beta = jax.nn.sigmoid(sc[:, :, :, 0])
    g = -jnp.exp(a_log.astype(jnp.float32)) * jax.nn.softplus(sc[:, :, :, 1] + dt_bias.astype(jnp.float32))
    return q, k, v, g, beta


def _gdn_chunk_scan(q, k, v, g, beta, s0, with_out):
    b_, l_, h_, dk = q.shape
    dv = v.shape[-1]
    n = l_ // DN_CHUNK

    def chunked(t):
        t = t.reshape((b_, n, DN_CHUNK, h_) + t.shape[3:])
        return jnp.moveaxis(jnp.moveaxis(t, 1, 0), 3, 2)

    qc = chunked(q) * dk ** -0.5
    kc, vc = chunked(k), chunked(v)
    bc = chunked(beta)
    gc = jnp.cumsum(chunked(g), axis=-1)
    idx = jnp.arange(DN_CHUNK)
    strict = idx[:, None] > idx[None, :]
    incl = idx[:, None] >= idx[None, :]
    diff = gc[..., :, None] - gc[..., None, :]
    kb = kc * bc[..., None]
    lmat = jnp.einsum('nbhid,nbhjd->nbhij', kb, kc) * jnp.exp(jnp.where(strict, diff, -jnp.inf))
    amat = lmat + jnp.eye(DN_CHUNK, dtype=lmat.dtype)
    rhs = jnp.concatenate([vc * bc[..., None], kb * jnp.exp(gc)[..., None]], axis=-1)
    sol = lax.linalg.triangular_solve(amat, rhs, left_side=True, lower=True, unit_diagonal=True)
    u, w = sol[..., :dv], sol[..., dv:]
    g_last = gc[..., -1]
    k_dec = kc * jnp.exp(g_last[..., None] - gc)[..., None]
    xs = (u, w, k_dec, g_last)
    if with_out:
        intra = jnp.einsum('nbhid,nbhjd->nbhij', qc, kc) * jnp.exp(jnp.where(incl, diff, -jnp.inf))
        q_dec = qc * jnp.exp(gc)[..., None]
        xs = xs + (q_dec, intra)

    def step(s, xs_i):
        u_i, w_i, kd_i, gl_i = xs_i[:4]
        v_new = u_i - jnp.einsum('bhck,bhkv->bhcv', w_i, s)
        s_new = s * jnp.exp(gl_i)[..., None, None] + jnp.einsum('bhck,bhcv->bhkv', kd_i, v_new)
        if with_out:
            qd_i, a_i = xs_i[4:]
            o_i = jnp.einsum('bhck,bhkv->bhcv', qd_i, s) + jnp.einsum('bhij,bhjv->bhiv', a_i, v_new)
            return s_new, o_i
        return s_new, None

    s_fin, o = lax.scan(step, s0, xs)
    if with_out:
        o = jnp.moveaxis(jnp.moveaxis(o, 2, 3), 0, 1).reshape(b_, l_, h_, dv)
    return o, s_fin


def _gdn_bidir(q, k, v, g, beta, s0_f, s0_b, with_out):
    flip = lambda t: jnp.flip(t, axis=1)
    o_f, s_f = _gdn_chunk_scan(q, k, v, g[:, :, 0], beta[:, :, 0], s0_f, with_out)
    o_b, s_b = _gdn_chunk_scan(flip(q), flip(k), flip(v), flip(g[:, :, 1]), flip(beta[:, :, 1]), s0_b, with_out)
    o = o_f + flip(o_b) if with_out else None
    return o, s_f, s_b


def _gated_head_norm(o, z, w, dtype):
    b_, l_ = o.shape[:2]
    return _rmsnorm(o.astype(dtype), w).reshape(b_, l_, D_DN) * jax.nn.silu(z)


def _softmax_with_sink(scores, sink):
    s = jnp.broadcast_to(sink[None, :, :, None, None], scores.shape[:-1] + (1,))
    p = jax.nn.softmax(jnp.concatenate([scores, s], axis=-1), axis=-1)
    return p[..., :-1]


def _latent_attention(q, k, v, k_ctx, v_ctx, sink):
    b_, l_, hq, d = q.shape
    group = hq // N_KV_HEADS
    nb = l_ // ATTN_BLOCK
    span = ATTN_BLOCK + 2 * WINDOW
    scale = d ** -0.5
    qg = q.reshape(b_, nb, ATTN_BLOCK, N_KV_HEADS, group, d)
    pad = ((0, 0), (WINDOW, WINDOW), (0, 0), (0, 0))
    kp, vp = jnp.pad(k, pad), jnp.pad(v, pad)
    offs_q = jnp.arange(ATTN_BLOCK)
    offs_k = jnp.arange(span) - WINDOW
    band = jnp.abs(offs_k[None, :] - offs_q[:, None]) <= WINDOW
    sink_g = sink.reshape(N_KV_HEADS, group).astype(jnp.float32)

    def one_block(i):
        q_i = qg[:, i]
        k_i = lax.dynamic_slice_in_dim(kp, i * ATTN_BLOCK, span, axis=1)
        v_i = lax.dynamic_slice_in_dim(vp, i * ATTN_BLOCK, span, axis=1)
        kpos = i * ATTN_BLOCK + offs_k
        valid = band & ((kpos >= 0) & (kpos < l_))[None, :]
        s_loc = jnp.einsum('bqhgd,bkhd->bhgqk', q_i, k_i).astype(jnp.float32) * scale
        s_loc = jnp.where(valid, s_loc, -jnp.inf)
        s_ctx = jnp.einsum('bqhgd,bkhd->bhgqk', q_i, k_ctx).astype(jnp.float32) * scale
        p = _softmax_with_sink(jnp.concatenate([s_loc, s_ctx], axis=-1), sink_g).astype(v.dtype)
        return (jnp.einsum('bhgqk,bkhd->bqhgd', p[..., :span], v_i)
                + jnp.einsum('bhgqk,bkhd->bqhgd', p[..., span:], v_ctx))

    out = lax.map(one_block, jnp.arange(nb))
    return jnp.moveaxis(out, 0, 1).reshape(b_, l_, hq * d)


def _context_attention(q, k, v, sink):
    b_, lc, hq, d = q.shape
    group = hq // N_KV_HEADS
    qg = q.reshape(b_, lc, N_KV_HEADS, group, d)
    s = jnp.einsum('bqhgd,bkhd->bhgqk', qg, k).astype(jnp.float32) * d ** -0.5
    p = _softmax_with_sink(s, sink.reshape(N_KV_HEADS, group).astype(jnp.float32)).astype(v.dtype)
    return jnp.einsum('bhgqk,bkhd->bqhgd', p, v).reshape(b_, lc, hq * d)


def _hybrid_layer(x, xc, c3, cc3, rows, cols, norm_w, ada_w, ada_b, w_in, conv_a_w, conv_a_b,
                  ln_a_w, ln_a_b, qkv_conv_w, a_log, dt_bias, dn_norm_w, sink, w_out, with_ctx_out):
    b_, l_ = x.shape[:2]
    lc = xc.shape[1]
    shift, scale, gate = _ada(c3, ada_w, ada_b)
    shift_c, scale_c, gate_c = _ada(cc3, ada_w, ada_b)
    h = _rmsnorm(x, norm_w) * (1.0 + scale) + shift
    hc = _rmsnorm(xc, norm_w) * (1.0 + scale_c) + shift_c
    (a_val, a_gate, z_a, q_b, k_b, v_b, z_b, sc_b, q_c, k_c, v_c, z_c) = _split_cols(h @ w_in)
    (a_val_x, a_gate_x, z_a_x, q_b_x, k_b_x, v_b_x, z_b_x, sc_b_x,
     q_c_x, k_c_x, v_c_x, z_c_x) = _split_cols(hc @ w_in)

    y_a = _conformer_conv(a_val, a_gate, z_a, conv_a_w, conv_a_b, ln_a_w, ln_a_b)

    s0 = jnp.zeros((b_, N_DN_HEADS, HEAD_DIM, HEAD_DIM), jnp.float32)
    gin_x = _gdn_inputs(q_b_x, k_b_x, v_b_x, sc_b_x, qkv_conv_w, a_log, dt_bias)
    o_bx, s_f, s_b = _gdn_bidir(*gin_x, s0, s0, with_ctx_out)
    gin = _gdn_inputs(q_b, k_b, v_b, sc_b, qkv_conv_w, a_log, dt_bias)
    o_b, _, _ = _gdn_bidir(*gin, s_f, s_b, True)
    y_b = _gated_head_norm(o_b, z_b, dn_norm_w, x.dtype)

    k_ctx = k_c_x.reshape(b_, lc, N_KV_HEADS, HEAD_DIM)
    v_ctx = v_c_x.reshape(b_, lc, N_KV_HEADS, HEAD_DIM)
    q_lat = _axial_rope(q_c.reshape(b_, l_, N_Q_HEADS, HEAD_DIM), rows, cols)
    k_lat = _axial_rope(k_c.reshape(b_, l_, N_KV_HEADS, HEAD_DIM), rows, cols)
    v_lat = v_c.reshape(b_, l_, N_KV_HEADS, HEAD_DIM)
    y_c = _latent_attention(q_lat, k_lat, v_lat, k_ctx, v_ctx, sink) * jax.nn.silu(z_c)

    y = jnp.concatenate([y_a, y_b, y_c], axis=-1) @ w_out
    x = x + gate * y

    if with_ctx_out:
        y_ax = _conformer_conv(a_val_x, a_gate_x, z_a_x, conv_a_w, conv_a_b, ln_a_w, ln_a_b)
        y_bx = _gated_head_norm(o_bx, z_b_x, dn_norm_w, xc.dtype)
        q_ctx = q_c_x.reshape(b_, lc, N_Q_HEADS, HEAD_DIM)
        y_cx = _context_attention(q_ctx, k_ctx, v_ctx, sink) * jax.nn.silu(z_c_x)
        yc = jnp.concatenate([y_ax, y_bx, y_cx], axis=-1) @ w_out
        xc = xc + gate_c * yc
    return x, xc


def setup_inputs(seed: int = 0) -> dict:
    key = jax.random.key(seed)
    ks = jax.random.split(key, 20)
    f32 = jnp.float32
    nrm = lambda k, s: jax.random.normal(k, s, f32)
    dt = jnp.exp(jax.random.uniform(ks[12], (DEPTH, 2, N_DN_HEADS), f32)
                 * (np.log(0.1) - np.log(0.001)) + np.log(0.001))
    return {
        "x": nrm(ks[0], (BATCH, SEQ, D_MODEL)),
        "c": nrm(ks[1], (BATCH, D_MODEL)),
        "ctx": nrm(ks[2], (BATCH, CTX_LEN, D_MODEL)),
        "c_ctx": nrm(ks[3], (D_MODEL,)),
        "norm_w": 1.0 + 0.1 * nrm(ks[4], (DEPTH, D_MODEL)),
        "ada_w": nrm(ks[5], (DEPTH, D_MODEL, 3 * D_MODEL)) * (0.5 * D_MODEL ** -0.5),
        "ada_b": 0.02 * nrm(ks[6], (DEPTH, 3 * D_MODEL)),
        "w_in": nrm(ks[7], (DEPTH, D_MODEL, N_IN)) * D_MODEL ** -0.5,
        "conv_a_w": nrm(ks[8], (DEPTH, CONV_WIDTH, D_CONV)) * CONV_WIDTH ** -0.5,
        "conv_a_b": 0.02 * nrm(ks[9], (DEPTH, D_CONV)),
        "ln_a_w": 1.0 + 0.1 * nrm(ks[10], (DEPTH, D_CONV)),
        "ln_a_b": 0.02 * nrm(ks[11], (DEPTH, D_CONV)),
        "qkv_conv_w": nrm(ks[13], (DEPTH, SHORT_CONV, 3 * D_DN)) * SHORT_CONV ** -0.5,
        "a_log": jnp.log(jax.random.uniform(ks[14], (DEPTH, 2, N_DN_HEADS), f32, 1.0, 16.0)),
        "dt_bias": dt + jnp.log(-jnp.expm1(-dt)),
        "dn_norm_w": 1.0 + 0.1 * nrm(ks[15], (DEPTH, HEAD_DIM)),
        "sink": nrm(ks[16], (DEPTH, N_Q_HEADS)),
        "w_out": nrm(ks[17], (DEPTH, D_MIX, D_MODEL)) * D_MIX ** -0.5,
        "final_norm_w": 1.0 + 0.1 * nrm(ks[18], (D_MODEL,)),
    }


def reference(x, c, ctx, c_ctx, norm_w, ada_w, ada_b, w_in, conv_a_w, conv_a_b, ln_a_w, ln_a_b,
              qkv_conv_w, a_log, dt_bias, dn_norm_w, sink, w_out, final_norm_w):
    n_tok = x.shape[1]
    n_rows = n_tok // GRID_W
    rows = jnp.repeat(jnp.arange(n_rows, dtype=jnp.int32), GRID_W)
    cols = jnp.tile(jnp.arange(GRID_W, dtype=jnp.int32), n_rows)
    c3 = c[:, None, :]
    cc3 = c_ctx[None, None, :]
    xc = ctx
    for l in range(DEPTH):
        x, xc = _hybrid_layer(x, xc, c3, cc3, rows, cols, norm_w[l], ada_w[l], ada_b[l], w_in[l],
                              conv_a_w[l], conv_a_b[l], ln_a_w[l], ln_a_b[l], qkv_conv_w[l],
                              a_log[l], dt_bias[l], dn_norm_w[l], sink[l], w_out[l],
                              l < DEPTH - 1)
    return _rmsnorm(x, final_norm_w)
```

```cpp
#include <hip/hip_runtime.h>
#include <hip/hip_bf16.h>
#include <hip/hip_cooperative_groups.h>
#include <cstdio>
namespace cg = cooperative_groups;

typedef __attribute__((ext_vector_type(8))) short bf16x8;
typedef __attribute__((ext_vector_type(4))) float f32x4;
typedef unsigned short u16;

#ifndef PROBE_MASK2
#define PROBE_MASK2 7
#endif
#ifndef PROBE_SYNC
#define PROBE_SYNC 0
#endif
#ifndef PROBE_MIX2
#define PROBE_MIX2 0
#endif
#ifndef PROBE_G1
#define PROBE_G1 0
#endif
#ifndef MIXMASK
#define MIXMASK 7
#endif
#ifndef MULTI_LAUNCH
#define MULTI_LAUNCH 0
#endif

constexpr int NL = 65536;
constexpr int NC = 4096;
constexpr int NT = NL + NC;
constexpr int PS = 3328;
constexpr int NWI = 3456;
constexpr int C_AVAL = 0, C_AGATE = 256, C_ZA = 512, C_QB = 768, C_KB = 1152, C_VB = 1536, C_ZB = 1920;
constexpr int C_QC = 2304, C_KC = 2688, C_VC = 2816, C_ZC = 2944;

constexpr size_t OFF_WI = 0;
constexpr size_t OFF_WO = OFF_WI + (size_t)4 * NWI * 1024 * 2;
constexpr size_t OFF_MOD = OFF_WO + (size_t)4 * 1024 * 1024 * 2;
constexpr size_t OFF_ROPE = OFF_MOD + (size_t)4 * 17 * 3072 * 4;
constexpr size_t OFF_CNT = OFF_ROPE + 64 * 16 * 2 * 4;
constexpr size_t OFF_XC = OFF_CNT + 256;
constexpr size_t OFF_SC = OFF_XC + (size_t)NC * 1024 * 4;
constexpr size_t OFF_P = OFF_SC + (size_t)NT * 32 * 4;
constexpr size_t OFF_H = OFF_P + (size_t)NT * PS * 2;
constexpr size_t OFF_OF = OFF_H + (size_t)NT * 1024 * 2;
constexpr size_t OFF_OB = OFF_OF + (size_t)NT * 384 * 4;
constexpr size_t OFF_BAR = OFF_OB + (size_t)NT * 384 * 4;
constexpr size_t OFF_GQ = OFF_BAR + 3456 * 4;
constexpr size_t WS_END = OFF_GQ + 64 * 4;

constexpr int SMEM_BYTES = 81728;

struct Params {
  const float *x, *c, *ctx, *c_ctx, *norm_w, *ada_w, *ada_b, *w_in, *conv_a_w, *conv_a_b, *ln_a_w, *ln_a_b,
      *qkv_conv_w, *a_log, *dt_bias, *dn_norm_w, *sink, *w_out, *final_norm_w;
  float* out;
  char* ws;
  int ph_lo, ph_hi;
};

__device__ __forceinline__ int opaque_tid(int wv) {
  unsigned m = ~0u;
  asm volatile("" : "+s"(m));
  int lane = __builtin_amdgcn_mbcnt_hi(m, __builtin_amdgcn_mbcnt_lo(m, 0u));
  int t = (wv << 6) | lane;
  asm volatile("" : "+v"(t));
  return t;
}
typedef __bf16 bf2_t __attribute__((ext_vector_type(2)));
typedef float f2_t __attribute__((ext_vector_type(2)));
__device__ __forceinline__ unsigned pack2(float a, float b) {
  f2_t v = {a, b};
  bf2_t r = __builtin_convertvector(v, bf2_t);
  union { bf2_t h; unsigned u; } cv;
  cv.h = r;
  return cv.u;
}
__device__ __forceinline__ u16 f2bf(float f) { return (u16)(pack2(f, 0.f) & 0xffffu); }
typedef float f4nt_t __attribute__((ext_vector_type(4)));
typedef unsigned u2nt_t __attribute__((ext_vector_type(2)));
__device__ __forceinline__ float4 ld_nt16(const float* p) { f4nt_t v = __builtin_nontemporal_load((const f4nt_t*)p); return make_float4(v.x, v.y, v.z, v.w); }
__device__ __forceinline__ uint2 ld_nt8(const u16* p) { u2nt_t v = __builtin_nontemporal_load((const u2nt_t*)p); return make_uint2(v.x, v.y); }
__device__ __forceinline__ void st_nt16(float* p, float a, float b, float c, float d) { f4nt_t v = {a, b, c, d}; __builtin_nontemporal_store(v, (f4nt_t*)p); }
typedef unsigned u4nt_t __attribute__((ext_vector_type(4)));
__device__ __forceinline__ uint4 ld_nt16u(const u16* p) { u4nt_t v = __builtin_nontemporal_load((const u4nt_t*)p); return make_uint4(v.x, v.y, v.z, v.w); }
__device__ __forceinline__ float bf2f(u16 h) { return __uint_as_float(((unsigned)h) << 16); }
__device__ __forceinline__ float sigmoidf_(float x) { return __builtin_amdgcn_rcpf(1.f + __expf(-x)); }
__device__ __forceinline__ float siluf_(float x) { return x * __builtin_amdgcn_rcpf(1.f + __expf(-x)); }
__device__ __forceinline__ float shx(float v, int off, int lane) {
  return __int_as_float(__builtin_amdgcn_ds_bpermute((lane ^ off) << 2, __float_as_int(v)));
}
__device__ __forceinline__ float shup(float v, int off, int lane) {
  int src = lane - off;
  src = src < 0 ? lane : src;
  return __int_as_float(__builtin_amdgcn_ds_bpermute(src << 2, __float_as_int(v)));
}
__device__ __forceinline__ float wsum(float v, int lane) {
#pragma unroll
  for (int o = 32; o > 0; o >>= 1) v += shx(v, o, lane);
  return v;
}
__device__ __forceinline__ f32x4 mfma16(bf16x8 a, bf16x8 b, f32x4 c) {
  return __builtin_amdgcn_mfma_f32_16x16x32_bf16(a, b, c, 0, 0, 0);
}
__device__ __forceinline__ void glds16(const void* g, void* l) {
  __builtin_amdgcn_global_load_lds((const __attribute__((address_space(1))) unsigned*)g,
                                   (__attribute__((address_space(3))) unsigned*)l, 16, 0, 0);
}

__device__ void phase_init(const Params& p, char* smem, int wv) {
  const int tid = opaque_tid(wv);
  const size_t gtid = (size_t)blockIdx.x * 256 + tid, gsz = (size_t)gridDim.x * 256;
  int* cnt = (int*)(p.ws + OFF_CNT);
  if (blockIdx.x == 0 && tid < 64) { cnt[tid] = 0; ((int*)(p.ws + OFF_GQ))[tid] = 0; }
  if (blockIdx.x == 0) { unsigned* bw = (unsigned*)(p.ws + OFF_BAR); for (int i = tid; i < 3456; i += 256) bw[i] = 0u; }
  float2* rope = (float2*)(p.ws + OFF_ROPE);
  for (size_t i = gtid; i < 64 * 16; i += gsz) {
    int pos = (int)i / 16, j = (int)i % 16;
    float inv = powf(10000.f, -(float)j / 16.f);
    float a = (float)pos * inv;
    rope[i] = make_float2(cosf(a), sinf(a));
  }
  {
    u16* Wi = (u16*)(p.ws + OFF_WI);
    u16* Wo = (u16*)(p.ws + OFF_WO);
    float* tl = (float*)smem;
    constexpr int NT_WI = 4 * 16 * (NWI / 64);
    for (int t = blockIdx.x; t < NT_WI + 4 * 16 * 16; t += gridDim.x) {
      const bool isWi = t < NT_WI;
      const int tt = isWi ? t : t - NT_WI;
      const int ntn = isWi ? NWI / 64 : 16;
      const int nt = tt % ntn, kt = (tt / ntn) % 16, l = tt / (ntn * 16);
      __syncthreads();
#pragma unroll
      for (int pass = 0; pass < 4; ++pass) {
        const int r = pass * 16 + (tid >> 4), c4 = (tid & 15) * 4;
        const int k = kt * 64 + r, n = nt * 64 + c4;
        float4 v = make_float4(0.f, 0.f, 0.f, 0.f);
        if (isWi) {
          const int glu_src = ((n & 63) < 32 ? 0 : 256 - 32) + (n >> 6) * 32 + (n & 63);
          const int src = n < 512 ? glu_src : (n < 2304 ? n : (n < 3328 ? n + 24 : (n < 3352 ? n - 1024 : -1)));
          if (src >= 0) v = *(const float4*)(p.w_in + ((size_t)l * 1024 + k) * 3352 + src);
        } else {
          v = *(const float4*)(p.w_out + ((size_t)l * 1024 + k) * 1024 + n);
        }
        tl[r * 65 + c4 + 0] = v.x; tl[r * 65 + c4 + 1] = v.y; tl[r * 65 + c4 + 2] = v.z; tl[r * 65 + c4 + 3] = v.w;
      }
      __syncthreads();
      {
        const int n = tid >> 2, kq = tid & 3;
        float f[16];
#pragma unroll
        for (int i = 0; i < 16; ++i) f[i] = tl[(kq * 16 + i) * 65 + n];
        u16* dst = (isWi ? Wi + ((size_t)l * NWI + nt * 64 + n) * 1024 : Wo + ((size_t)l * 1024 + nt * 64 + n) * 1024) + kt * 64 + kq * 16;
        *(uint4*)dst = make_uint4(pack2(f[0], f[1]), pack2(f[2], f[3]), pack2(f[4], f[5]), pack2(f[6], f[7]));
        *(uint4*)(dst + 8) = make_uint4(pack2(f[8], f[9]), pack2(f[10], f[11]), pack2(f[12], f[13]), pack2(f[14], f[15]));
      }
    }
    __syncthreads();
  }
  float* mod = (float*)(p.ws + OFF_MOD);
  float* scond = (float*)smem;
  const int lane = tid & 63, wave = tid >> 6;
  for (int item = blockIdx.x; item < 192; item += gridDim.x) {
    __syncthreads();
    for (int i = tid; i < 17 * 1024; i += 256) {
      int r = i >> 10, k = i & 1023;
      float v = r < 16 ? p.c[r * 1024 + k] : p.c_ctx[k];
      scond[i] = siluf_(v);
    }
    __syncthreads();
    int l = item / 48, j = (item % 48) * 64 + lane;
    float acc[17];
#pragma unroll
    for (int r = 0; r < 17; ++r) acc[r] = 0.f;
    const float* aw = p.ada_w + (size_t)l * 1024 * 3072 + j;
    for (int k4 = 0; k4 < 64; ++k4) {
      int k = wave * 256 + k4 * 4;
      float w0 = aw[(size_t)(k + 0) * 3072], w1 = aw[(size_t)(k + 1) * 3072], w2 = aw[(size_t)(k + 2) * 3072],
            w3 = aw[(size_t)(k + 3) * 3072];
#pragma unroll
      for (int r = 0; r < 17; ++r) {
        float4 s = *(const float4*)(scond + r * 1024 + k);
        acc[r] += s.x * w0 + s.y * w1 + s.z * w2 + s.w * w3;
      }
    }
    __syncthreads();
    float* red = (float*)smem;
#pragma unroll
    for (int r = 0; r < 17; ++r) red[(wave * 17 + r) * 64 + lane] = acc[r];
    __syncthreads();
    for (int i = tid; i < 17 * 64; i += 256) {
      int r = i / 64, jj = i % 64;
      float s = red[(0 * 17 + r) * 64 + jj] + red[(1 * 17 + r) * 64 + jj] + red[(2 * 17 + r) * 64 + jj] +
                red[(3 * 17 + r) * 64 + jj];
      int col = (item % 48) * 64 + jj;
      mod[((size_t)l * 17 + r) * 3072 + col] = s + p.ada_b[l * 3072 + col];
    }
  }
}

__device__ void phase_norm(const Params& p, int l, int wv) {
  const int tid = opaque_tid(wv), lane = tid & 63, wave = tid >> 6;
  const float* xl = l == 0 ? p.x : p.out;
  const float* xc = l == 0 ? p.ctx : (const float*)(p.ws + OFF_XC);
  const float* mod = (const float*)(p.ws + OFF_MOD) + (size_t)l * 17 * 3072;
  const float* nw = p.norm_w + l * 1024;
  u16* H = (u16*)(p.ws + OFF_H);
  for (int g = blockIdx.x * 4 + wave; g < NT / 4; g += gridDim.x * 4) {
    const int row0 = g * 4;
    const float* xr = row0 < NL ? xl + (size_t)row0 * 1024 : xc + (size_t)(row0 - NL) * 1024;
    const float* m = mod + (row0 < NL ? (row0 >> 12) : 16) * 3072;
    float4 v[4][4];
#pragma unroll
    for (int rr = 0; rr < 4; ++rr)
#pragma unroll
      for (int i = 0; i < 4; ++i) v[rr][i] = ld_nt16(xr + (size_t)rr * 1024 + (lane + 64 * i) * 4);
    float ss[4];
#pragma unroll
    for (int rr = 0; rr < 4; ++rr) {
      ss[rr] = 0.f;
#pragma unroll
      for (int i = 0; i < 4; ++i)
        ss[rr] += v[rr][i].x * v[rr][i].x + v[rr][i].y * v[rr][i].y + v[rr][i].z * v[rr][i].z + v[rr][i].w * v[rr][i].w;
    }
#pragma unroll
    for (int o = 32; o > 0; o >>= 1) {
#pragma unroll
      for (int rr = 0; rr < 4; ++rr) ss[rr] += shx(ss[rr], o, lane);
    }
    float r[4];
#pragma unroll
    for (int rr = 0; rr < 4; ++rr) r[rr] = rsqrtf(ss[rr] * (1.f / 1024.f) + 1e-6f);
#pragma unroll
    for (int i = 0; i < 4; ++i) {
      int c = (lane + 64 * i) * 4;
      float4 w = *(const float4*)(nw + c);
      float4 sh = *(const float4*)(m + c);
      float4 sc = *(const float4*)(m + 1024 + c);
      float a0 = w.x * (1.f + sc.x), a1 = w.y * (1.f + sc.y), a2 = w.z * (1.f + sc.z), a3 = w.w * (1.f + sc.w);
#pragma unroll
      for (int rr = 0; rr < 4; ++rr) {
        float h0 = v[rr][i].x * r[rr] * a0 + sh.x;
        float h1 = v[rr][i].y * r[rr] * a1 + sh.y;
        float h2 = v[rr][i].z * r[rr] * a2 + sh.z;
        float h3 = v[rr][i].w * r[rr] * a3 + sh.w;
        *(uint2*)(H + (size_t)(row0 + rr) * 1024 + c) = make_uint2(pack2(h0, h1), pack2(h2, h3));
      }
    }
  }
}

template <int MODE>
__device__ void phase_gemm(const Params& p, int l, char* smem, int mtiles, int* s_item, int wv) {
  const int tid = opaque_tid(wv), lane = tid & 63, wave = tid >> 6;
  const int wr = wave >> 1, wc = wave & 1, fr = lane & 15, fq = lane >> 4;
  const u16* A = (const u16*)(p.ws + OFF_H);
  const u16* Bt = MODE == 1 ? (const u16*)(p.ws + OFF_WI) + (size_t)l * NWI * 1024
                            : (const u16*)(p.ws + OFF_WO) + (size_t)l * 1024 * 1024;
  constexpr int NTN = MODE == 1 ? 27 : 8;
  const int xcd = (int)(((unsigned)__builtin_amdgcn_s_getreg((3 << 11) | 20)) & 7u);
  int* gq = (int*)(p.ws + OFF_GQ) + (l * 2 + (MODE - 1)) * 8;
  const int mp = mtiles >> 3;
  const int per_xcd = mp * NTN;
  for (int s8 = 0; s8 < 8; ++s8) {
  const int stripe = (xcd + s8) & 7;
  for (;;) {
    __syncthreads();
    if (tid == 0) *s_item = atomicAdd(gq + stripe, 1);
    __syncthreads();
    const int u = *s_item;
    if (u >= per_xcd) break;
    constexpr int GP = 3;
    const int g = u / (GP * NTN);
    const int r = u - g * GP * NTN;
    const int gs = min(GP, mp - g * GP);
    const int tm = stripe * mp + g * GP + r % gs, tn = r / gs;
    const int brow = tm * 256, bcol = tn * 128;
    f32x4 acc[8][4];
#pragma unroll
    for (int m = 0; m < 8; ++m)
#pragma unroll
      for (int n = 0; n < 4; ++n) acc[m][n] = (f32x4){0.f, 0.f, 0.f, 0.f};
    const unsigned voff = (unsigned)(((tid >> 2) * 1024 + ((tid & 3) ^ ((tid >> 4) & 3)) * 8) * 2);
    auto stage = [&](int kt, int buf) {
      char* SA = smem + buf * 24576;
      char* SB = SA + 16384;
      const char* ab = (const char*)A + ((size_t)brow * 1024 + kt * 32) * 2;
      const char* bb = (const char*)Bt + ((size_t)bcol * 1024 + kt * 32) * 2;
#pragma unroll
      for (int i = 0; i < 4; ++i) glds16(ab + (size_t)i * (64 * 2048) + voff, SA + tid * 16 + i * 4096);
#pragma unroll
      for (int i = 0; i < 2; ++i) glds16(bb + (size_t)i * (64 * 2048) + voff, SB + tid * 16 + i * 4096);
    };
    __syncthreads();
    stage(0, 0);
    stage(1, 1);
    int buf = 0;
    for (int kt = 0; kt < 32; ++kt) {
      if (kt < 31) asm volatile("s_waitcnt vmcnt(6)" ::: "memory");
      else asm volatile("s_waitcnt vmcnt(0)" ::: "memory");
      __builtin_amdgcn_s_barrier();
      int nb = buf + 2; nb = nb >= 3 ? nb - 3 : nb;
      if (kt + 2 < 32) stage(kt + 2, nb);
      const char* SA = smem + buf * 24576;
      const char* SB = SA + 16384;
      bf16x8 af[8], bfr[4];
#pragma unroll
      for (int n = 0; n < 4; ++n) bfr[n] = *(const bf16x8*)(SB + (wc * 64 + n * 16 + fr) * 64 + (fq ^ (fr >> 2)) * 16);
#pragma unroll
      for (int m = 0; m < 8; ++m) af[m] = *(const bf16x8*)(SA + (wr * 128 + m * 16 + fr) * 64 + (fq ^ (fr >> 2)) * 16);
      __builtin_amdgcn_sched_barrier(0);
      __builtin_amdgcn_s_setprio(1);
#pragma unroll
      for (int m = 0; m < 8; ++m)
#pragma unroll
        for (int n = 0; n < 4; ++n) acc[m][n] = mfma16(bfr[n], af[m], acc[m][n]);
      __builtin_amdgcn_s_setprio(0);
      buf = buf + 1 == 3 ? 0 : buf + 1;
    }
    int tid_e = tid;
    asm volatile("" : "+v"(tid_e));
    const int fr = tid_e & 15, fq = (tid_e >> 4) & 3, wr = tid_e >> 7, wc = (tid_e >> 6) & 1;
    const int col0 = bcol + wc * 64;
    if (MODE == 1) {
      u16* P = (u16*)(p.ws + OFF_P);
      float* SC = (float*)(p.ws + OFF_SC);
      const float2* rope = (const float2*)(p.ws + OFF_ROPE);
      if (col0 >= 3328) {
        if (col0 == 3328) {
#pragma unroll
          for (int m = 0; m < 8; ++m) {
            int row = brow + wr * 128 + m * 16 + fr;
#pragma unroll
            for (int n = 0; n < 2; ++n)
              *(float4*)(SC + (size_t)row * 32 + n * 16 + fq * 4) =
                  make_float4(acc[m][n][0], acc[m][n][1], acc[m][n][2], acc[m][n][3]);
          }
        }
      } else {
        const bool ropecols = col0 >= C_QC && col0 < C_VC;
        const bool isq = col0 >= C_QC && col0 < C_KC;
#pragma unroll
        for (int m = 0; m < 8; ++m) {
          int row = brow + wr * 128 + m * 16 + fr;
          if (ropecols && row < NL) {
            int tpos = row & 4095;
#pragma unroll
            for (int pr = 0; pr < 2; ++pr) {
              int pos = pr == 0 ? (tpos >> 6) : (tpos & 63);
#pragma unroll
              for (int j = 0; j < 4; ++j) {
                float2 cs = rope[pos * 16 + fq * 4 + j];
                float x1 = acc[m][2 * pr][j], x2 = acc[m][2 * pr + 1][j];
                acc[m][2 * pr][j] = x1 * cs.x - x2 * cs.y;
                acc[m][2 * pr + 1][j] = x2 * cs.x + x1 * cs.y;
              }
            }
          }
          float sc = isq ? 0.125f * 1.44269504088896f : 1.f;
          if (col0 < 512) {
#pragma unroll
            for (int n = 0; n < 2; ++n) {
              *(uint2*)(P + (size_t)row * PS + (col0 >> 1) + n * 16 + fq * 4) =
                  make_uint2(pack2(acc[m][n][0] * sigmoidf_(acc[m][n + 2][0]), acc[m][n][1] * sigmoidf_(acc[m][n + 2][1])),
                             pack2(acc[m][n][2] * sigmoidf_(acc[m][n + 2][2]), acc[m][n][3] * sigmoidf_(acc[m][n + 2][3])));
            }
          } else {
#pragma unroll
          for (int n = 0; n < 4; ++n) {
            *(uint2*)(P + (size_t)row * PS + col0 + n * 16 + fq * 4) =
                make_uint2(pack2(acc[m][n][0] * sc, acc[m][n][1] * sc), pack2(acc[m][n][2] * sc, acc[m][n][3] * sc));
          }
          }
        }
      }
    } else {
      const float* xl = l == 0 ? p.x : p.out;
      const float* xc = l == 0 ? p.ctx : (const float*)(p.ws + OFF_XC);
      float* XC = (float*)(p.ws + OFF_XC);
      const float* mod = (const float*)(p.ws + OFF_MOD) + (size_t)l * 17 * 3072;
#pragma unroll
      for (int m = 0; m < 8; ++m) {
        int row = brow + wr * 128 + m * 16 + fr;
        const float* xo = row < NL ? xl + (size_t)row * 1024 : xc + (size_t)(row - NL) * 1024;
        float* xn = row < NL ? p.out + (size_t)row * 1024 : XC + (size_t)(row - NL) * 1024;
        const float* g = mod + (row < NL ? (row >> 12) : 16) * 3072 + 2048;
#pragma unroll
        for (int n = 0; n < 4; ++n) {
          int c = col0 + n * 16 + fq * 4;
          float4 xv = *(const float4*)(xo + c);
          float4 gv = *(const float4*)(g + c);
          xv.x += gv.x * acc[m][n][0];
          xv.y += gv.y * acc[m][n][1];
          xv.z += gv.z * acc[m][n][2];
          xv.w += gv.w * acc[m][n][3];
          *(float4*)(xn + c) = xv;
        }
      }
    }
  }
  }
}

__device__ void conv_item(const Params& p, int l, int item, char* smem, int wv) {
  float* u = (float*)smem;
  const int tid = opaque_tid(wv), lane = tid & 63, wave = tid >> 6;
  const int g0 = item * 32;
  int s0, s1;
  if (g0 < NL) { s0 = (g0 >> 12) << 12; s1 = s0 + 4096; }
  else { s0 = NL + (((g0 - NL) >> 8) << 8); s1 = s0 + 256; }
  const u16* P = (const u16*)(p.ws + OFF_P);
  {
    uint4 va[8];
#pragma unroll
    for (int q = 0; q < 8; ++q) {
      int idx = tid + 256 * q;
      int r = idx >> 5, c8 = idx & 31;
      int g = g0 - 15 + r;
      va[q] = make_uint4(0, 0, 0, 0);
      if (r < 62 && g >= s0 && g < s1) va[q] = *(const uint4*)(P + (size_t)g * PS + C_AVAL + c8 * 8);
    }
#pragma unroll
    for (int q = 0; q < 8; ++q) {
      int idx = tid + 256 * q;
      int r = idx >> 5, c8 = idx & 31;
      if (r < 62) {
        unsigned aw[4] = {va[q].x, va[q].y, va[q].z, va[q].w};
        *(float4*)(u + r * 256 + c8 * 8) = make_float4(__uint_as_float(aw[0] << 16), __uint_as_float(aw[0] & 0xffff0000u),
                                                       __uint_as_float(aw[1] << 16), __uint_as_float(aw[1] & 0xffff0000u));
        *(float4*)(u + r * 256 + c8 * 8 + 4) = make_float4(__uint_as_float(aw[2] << 16), __uint_as_float(aw[2] & 0xffff0000u),
                                                           __uint_as_float(aw[3] << 16), __uint_as_float(aw[3] & 0xffff0000u));
      }
    }
  }
  __syncthreads();
  float w[31];
#pragma unroll
  for (int k = 0; k < 31; ++k) w[k] = p.conv_a_w[((size_t)l * 31 + k) * 256 + tid];
  const float cb = p.conv_a_b[l * 256 + tid];
#pragma unroll 1
  for (int t0 = 0; t0 < 32; t0 += 8) {
    float uv[38];
#pragma unroll
    for (int i = 0; i < 38; ++i) uv[i] = u[(t0 + i) * 256 + tid];
    __builtin_amdgcn_sched_barrier(0);
    float a[8];
#pragma unroll
    for (int j = 0; j < 8; ++j) a[j] = cb;
#pragma unroll
    for (int k = 0; k < 31; ++k)
#pragma unroll
      for (int j = 0; j < 8; ++j) a[j] += w[k] * uv[j + k];
#pragma unroll
    for (int j = 0; j < 8; ++j) u[(t0 + j) * 256 + tid] = a[j];
  }
  __syncthreads();
  u16* MIX = (u16*)(p.ws + OFF_H);
  const float4 lw = *(const float4*)(p.ln_a_w + l * 256 + lane * 4);
  const float4 lb = *(const float4*)(p.ln_a_b + l * 256 + lane * 4);
  uint2 zzv[8];
#pragma unroll
  for (int tt = 0; tt < 8; ++tt) zzv[tt] = ld_nt8(P + (size_t)(g0 + wave * 8 + tt) * PS + C_ZA + lane * 4);
#pragma unroll
  for (int tt = 0; tt < 8; ++tt) {
    int t = wave * 8 + tt;
    float4 v = *(const float4*)(u + t * 256 + lane * 4);
    float mean = wsum(v.x + v.y + v.z + v.w, lane) * (1.f / 256.f);
    float d0 = v.x - mean, d1 = v.y - mean, d2 = v.z - mean, d3 = v.w - mean;
    float var = wsum(d0 * d0 + d1 * d1 + d2 * d2 + d3 * d3, lane) * (1.f / 256.f);
    float rs = rsqrtf(var + 1e-6f);
    size_t row = (size_t)(g0 + t);
    uint2 zz = zzv[tt];
    float z0 = bf2f((u16)(zz.x & 0xffff)), z1 = bf2f((u16)(zz.x >> 16)), z2 = bf2f((u16)(zz.y & 0xffff)),
          z3 = bf2f((u16)(zz.y >> 16));
    float o0 = siluf_(d0 * rs * lw.x + lb.x) * siluf_(z0);
    float o1 = siluf_(d1 * rs * lw.y + lb.y) * siluf_(z1);
    float o2 = siluf_(d2 * rs * lw.z + lb.z) * siluf_(z2);
    float o3 = siluf_(d3 * rs * lw.w + lb.w) * siluf_(z3);
    *(uint2*)(MIX + row * 1024 + lane * 4) = make_uint2(pack2(o0, o1), pack2(o2, o3));
  }
}

__device__ void attn_item(const Params& p, int l, int item, char* smem, int wv) {
  const int tid = opaque_tid(wv), lane = tid & 63, wave = tid >> 6, fr = lane & 15, fq = lane >> 4;
  u16* Ks = (u16*)smem;
  u16* Vt = Ks + 64 * 72;
  const u16* P = (const u16*)(p.ws + OFF_P);
  bool latent;
  int b, qb, head;
  if (item < 3072) { latent = true; b = item / 192; qb = (item / 6) % 32; head = item % 6; }
  else { int it = item - 3072; latent = false; b = it / 12; qb = (it / 6) % 2; head = it % 6; }
  const int kvh = head / 3;
  const size_t qrow0 = (latent ? (size_t)b * 4096 : (size_t)NL + b * 256) + qb * 128 + wave * 32;
  bf16x8 qf[2][2];
#pragma unroll
  for (int qt = 0; qt < 2; ++qt)
#pragma unroll
    for (int ds = 0; ds < 2; ++ds)
      qf[qt][ds] = *(const bf16x8*)(P + (qrow0 + qt * 16 + fr) * PS + C_QC + head * 64 + ds * 32 + fq * 8);
  const float sinkv = p.sink[l * 6 + head] * 1.44269504088896f;
  float mrow[2] = {sinkv, sinkv};
  float lp[2];
  lp[0] = lp[1] = (fq == 0) ? 1.f : 0.f;
  f32x4 o[2][4];
#pragma unroll
  for (int qt = 0; qt < 2; ++qt)
#pragma unroll
    for (int dt = 0; dt < 4; ++dt) o[qt][dt] = (f32x4){0.f, 0.f, 0.f, 0.f};
  const int tlo = latent ? (qb == 0 ? 2 : 0) : 0;
  const int thi = latent ? min(6, 66 - 2 * qb) : 0;
  const int nl = thi - tlo;
  const int ntile = nl + 4;
  const int qw0 = qb * 128 + wave * 32;
  char* stg = (char*)(Vt + 64 * 72);
  auto tile_row0 = [&](int si, bool& local, int& kb0) -> size_t {
    local = si < nl;
    kb0 = local ? qb * 128 - 128 + (tlo + si) * 64 : (si - nl) * 64;
    return local ? (size_t)b * 4096 + kb0 : (size_t)NL + b * 256 + kb0;
  };
  auto prefetch = [&](int si) {
    bool lc; int k0;
    size_t krow0 = tile_row0(si, lc, k0);
#pragma unroll
    for (int rep = 0; rep < 2; ++rep) {
      int idx = tid + rep * 256;
      int key = idx >> 3, s8 = idx & 7;
      glds16(P + (krow0 + key) * PS + C_KC + kvh * 64 + s8 * 8, stg + idx * 16);
      glds16(P + (krow0 + key) * PS + C_VC + kvh * 64 + s8 * 8, stg + 8192 + idx * 16);
    }
  };
  __syncthreads();
  prefetch(0);
  for (int si = 0; si < ntile; ++si) {
    bool local; int kb0;
    tile_row0(si, local, kb0);
    asm volatile("s_waitcnt vmcnt(0)" ::: "memory");
    __syncthreads();
#pragma unroll
    for (int rep = 0; rep < 2; ++rep) {
      int idx = tid + rep * 256;
      int key = idx >> 3, s8 = idx & 7;
      uint4 kv = *(const uint4*)(stg + idx * 16);
      uint4 vv = *(const uint4*)(stg + 8192 + idx * 16);
      *(uint4*)(Ks + key * 72 + s8 * 8) = kv;
      unsigned vw[4] = {vv.x, vv.y, vv.z, vv.w};
#pragma unroll
      for (int e = 0; e < 4; ++e) {
        Vt[(s8 * 8 + 2 * e) * 72 + key] = (u16)(vw[e] & 0xffff);
        Vt[(s8 * 8 + 2 * e + 1) * 72 + key] = (u16)(vw[e] >> 16);
      }
    }
    __syncthreads();
    if (local && (kb0 + 63 < qw0 - 128 || kb0 > qw0 + 31 + 128)) {
      if (si + 1 < ntile) prefetch(si + 1);
      continue;
    }
    bf16x8 kf[4][2];
#pragma unroll
    for (int kt = 0; kt < 4; ++kt)
#pragma unroll
      for (int ds = 0; ds < 2; ++ds) kf[kt][ds] = *(const bf16x8*)(Ks + (kt * 16 + fr) * 72 + ds * 32 + fq * 8);
    bf16x8 vf[4][2];
#pragma unroll
    for (int dt = 0; dt < 4; ++dt)
#pragma unroll
      for (int k2 = 0; k2 < 2; ++k2) {
        uint2 a = *(const uint2*)(Vt + (dt * 16 + fr) * 72 + k2 * 32 + fq * 4);
        uint2 c = *(const uint2*)(Vt + (dt * 16 + fr) * 72 + k2 * 32 + 16 + fq * 4);
        union { uint4 u; bf16x8 v; } cv;
        cv.u = make_uint4(a.x, a.y, c.x, c.y);
        vf[dt][k2] = cv.v;
      }
    __builtin_amdgcn_sched_barrier(0);
    if (si + 1 < ntile) prefetch(si + 1);
    __builtin_amdgcn_sched_barrier(0);
#pragma unroll
    for (int qt = 0; qt < 2; ++qt) {
      f32x4 s[4];
#pragma unroll
      for (int kt = 0; kt < 4; ++kt) {
        s[kt] = (f32x4){0.f, 0.f, 0.f, 0.f};
#pragma unroll
        for (int ds = 0; ds < 2; ++ds) s[kt] = mfma16(kf[kt][ds], qf[qt][ds], s[kt]);
      }
      if (local && !(kb0 >= qw0 + 31 - 128 && kb0 + 63 <= qw0 + 128)) {
        int qpos = qw0 + qt * 16 + fr;
#pragma unroll
        for (int kt = 0; kt < 4; ++kt)
#pragma unroll
          for (int j = 0; j < 4; ++j) {
            int kpos = kb0 + kt * 16 + fq * 4 + j;
            int d = kpos - qpos;
            if (d > 128 || d < -128) s[kt][j] = -INFINITY;
          }
      }
      float mx = -INFINITY;
#pragma unroll
      for (int kt = 0; kt < 4; ++kt)
#pragma unroll
        for (int j = 0; j < 4; ++j) mx = fmaxf(mx, s[kt][j]);
      mx = fmaxf(mx, shx(mx, 16, lane));
      mx = fmaxf(mx, shx(mx, 32, lane));
      float mnew = fmaxf(mrow[qt], mx);
      float alpha = __builtin_amdgcn_exp2f(mrow[qt] - mnew);
      mrow[qt] = mnew;
      float psum = 0.f;
#pragma unroll
      for (int kt = 0; kt < 4; ++kt)
#pragma unroll
        for (int j = 0; j < 4; ++j) {
          float pv = __builtin_amdgcn_exp2f(s[kt][j] - mnew);
          s[kt][j] = pv;
          psum += pv;
        }
      lp[qt] = lp[qt] * alpha + psum;
#pragma unroll
      for (int dt = 0; dt < 4; ++dt) {
        o[qt][dt][0] *= alpha; o[qt][dt][1] *= alpha; o[qt][dt][2] *= alpha; o[qt][dt][3] *= alpha;
      }
#pragma unroll
      for (int k2 = 0; k2 < 2; ++k2) {
        union { uint4 u; bf16x8 v; } pf;
        pf.u = make_uint4(pack2(s[2 * k2][0], s[2 * k2][1]), pack2(s[2 * k2][2], s[2 * k2][3]),
                          pack2(s[2 * k2 + 1][0], s[2 * k2 + 1][1]), pack2(s[2 * k2 + 1][2], s[2 * k2 + 1][3]));
#pragma unroll
        for (int dt = 0; dt < 4; ++dt) o[qt][dt] = mfma16(vf[dt][k2], pf.v, o[qt][dt]);
      }
    }
  }
  u16* MIX = (u16*)(p.ws + OFF_H);
#pragma unroll
  for (int qt = 0; qt < 2; ++qt) {
    float lt = lp[qt];
    lt += shx(lt, 16, lane);
    lt += shx(lt, 32, lane);
    float inv = 1.f / lt;
    size_t row = qrow0 + qt * 16 + fr;
#pragma unroll
    for (int dt = 0; dt < 4; ++dt) {
      int d = dt * 16 + fq * 4;
      uint2 zz = ld_nt8(P + row * PS + C_ZC + head * 64 + d);
      float z0 = bf2f((u16)(zz.x & 0xffff)), z1 = bf2f((u16)(zz.x >> 16)), z2 = bf2f((u16)(zz.y & 0xffff)),
            z3 = bf2f((u16)(zz.y >> 16));
      float o0 = o[qt][dt][0] * inv * siluf_(z0);
      float o1 = o[qt][dt][1] * inv * siluf_(z1);
      float o2 = o[qt][dt][2] * inv * siluf_(z2);
      float o3 = o[qt][dt][3] * inv * siluf_(z3);
      *(uint2*)(MIX + row * 1024 + 640 + head * 64 + d) = make_uint2(pack2(o0, o1), pack2(o2, o3));
    }
  }
}

__device__ __forceinline__ void mm64(const u16* A, const u16* Bt, int wave, int fr, int fq, f32x4 acc[4]) {
#pragma unroll
  for (int kk = 0; kk < 2; ++kk) {
    bf16x8 a = *(const bf16x8*)(A + (16 * wave + fr) * 72 + kk * 32 + fq * 8);
#pragma unroll
    for (int n = 0; n < 4; ++n) {
      bf16x8 bb = *(const bf16x8*)(Bt + (n * 16 + fr) * 72 + kk * 32 + fq * 8);
      acc[n] = mfma16(a, bb, acc[n]);
    }
  }
}

__device__ __forceinline__ f32x4 mfma4f(float a, float b, f32x4 c) {
  return __builtin_amdgcn_mfma_f32_16x16x4f32(a, b, c, 0, 0, 0);
}

__device__ __forceinline__ void lds_barrier() {
  asm volatile("s_waitcnt lgkmcnt(0)" ::: "memory");
  __builtin_amdgcn_s_barrier();
  asm volatile("" ::: "memory");
}

__device__ void dn_item(const Params& p, int l, int item, char* smem, int wv) {
  const int tid = opaque_tid(wv), lane = tid & 63, wave = tid >> 6, fr = lane & 15, fq = lane >> 4;
  const int b = item / 12, h = (item / 2) % 6, dir = item & 1;
  constexpr int RS = 200;
  constexpr int XS = 68;
  u16* R0 = (u16*)smem;
  float* LfT = (float*)smem;
  u16* Ib = (u16*)(smem + 17408);
  u16* VnT = (u16*)smem;
  u16* Kb = (u16*)(smem + 27200);
  u16* Vb = Kb + 4608;
  u16* Qb = Vb + 4608;
  float* X = (float*)(smem + 27200);
  u16* KdT = (u16*)(smem + 27200 + 27648);
  u16* Stb = KdT + 4608;
  float* gcs = (float*)(smem + 73280);
  float* bts = gcs + 64;
  float* Tinv = (float*)(smem + 73792);
  float* cw = (float*)(smem + 77888);
  const u16* P = (const u16*)(p.ws + OFF_P);
  const float* SC = (const float*)(p.ws + OFF_SC);
  u16* Obuf = (u16*)(p.ws + (dir ? OFF_OB : OFF_OF));
  const float aexp = expf(p.a_log[l * 12 + dir * 6 + h]);
  const float dtb = p.dt_bias[l * 12 + dir * 6 + h];
  f32x4 S[4];
#pragma unroll
  for (int n = 0; n < 4; ++n) S[n] = (f32x4){0.f, 0.f, 0.f, 0.f};
  __syncthreads();
  for (int i = tid; i < 64 * 72; i += 256) Stb[i] = 0;
  for (int i = tid; i < 960; i += 256) {
    int k = i / 192, c = i % 192, part = c >> 6, d = c & 63;
    cw[i] = p.qkv_conv_w[((size_t)l * 5 + k) * 1152 + part * 384 + h * 64 + d];
  }
  uint4 pre[7];
  float scb = 0.f, scg = 0.f;
  auto chunk_info = [&](int step, size_t& gbase, int& tb, int& Ls) {
    const bool isctx = step < 4;
    const int ci = isctx ? step : step - 4;
    const int nch = isctx ? 4 : 64;
    const int chunk = dir ? nch - 1 - ci : ci;
    Ls = isctx ? 256 : 4096;
    gbase = isctx ? (size_t)NL + b * 256 : (size_t)b * 4096;
    tb = chunk * 64;
  };
  auto prefetch = [&](int step) {
    size_t gbase; int tb, Ls;
    chunk_info(step, gbase, tb, Ls);
    int tl = tid;
    asm volatile("" : "+v"(tl));
    const int rr = tl / 24, seg = tl - rr * 24, part = seg >> 3, s8 = seg & 7;
    const u16* src = P + (gbase + tb - 2 + rr) * PS + C_QB + part * 384 + h * 64 + s8 * 8;
#pragma unroll
    for (int q = 0; q < 7; ++q) {
      int r = rr + 10 * q;
      int t = tb - 2 + r;
      uint4 val = make_uint4(0, 0, 0, 0);
      if (tl < 240 && r < 68 && t >= 0 && t < Ls) val = *(const uint4*)(src + (size_t)(10 * q) * PS);
      pre[q] = val;
    }
    if (wave == 0) {
      int tok = tb + (dir ? 63 - lane : lane);
      const float* sc = SC + (gbase + tok) * 32 + dir * 12;
      scb = sc[h];
      scg = sc[6 + h];
    }
  };
  auto commit = [&]() {
    int tl = tid;
    asm volatile("" : "+v"(tl));
    const int rr = tl / 24, seg = tl - rr * 24, part = seg >> 3, s8 = seg & 7;
#pragma unroll
    for (int q = 0; q < 7; ++q) {
      int r = rr + 10 * q;
      if (tl < 240 && r < 68) *(uint4*)(R0 + r * RS + part * 64 + s8 * 8) = pre[q];
    }
    if (wave == 0) {
      float bet = sigmoidf_(scb);
      float xx = scg + dtb;
      float ex = __expf(xx);
      float sp = xx > 20.f ? xx : (ex < 0.01f ? ex * (1.f - ex * (0.5f - ex * (1.f / 3.f))) : __logf(1.f + ex));
      float g = -aexp * sp;
#pragma unroll
      for (int off = 1; off < 64; off <<= 1) {
        float tv = shup(g, off, lane);
        if (lane >= off) g += tv;
      }
      gcs[lane] = g;
      bts[lane] = bet;
    }
  };
  prefetch(0);
  commit();
  __syncthreads();

  for (int step = 0; step < 68; ++step) {
    size_t gbase; int tb, Ls;
    chunk_info(step, gbase, tb, Ls);
    const bool need_out = (step >= 4) || (l < 3);
    {
      const int ti = tid >> 2, dc = tid & 3;
      const int ip = dir ? 63 - ti : ti;
      const float ekd = __expf(gcs[63] - gcs[ip]);
#pragma unroll
      for (int part = 0; part < 3; ++part) {
        float acc[16];
#pragma unroll
        for (int e = 0; e < 16; ++e) acc[e] = 0.f;
#pragma unroll
        for (int kb2 = 0; kb2 < 2; ++kb2) {
          const int k0 = kb2 * 3, nk = kb2 ? 2 : 3;
          uint4 rv[3][2];
          float4 wv4[3][4];
#pragma unroll
          for (int kq = 0; kq < 3; ++kq) {
            if (kq < nk) {
              const int kk = k0 + kq;
              const u16* rr = R0 + (ti + kk) * RS + part * 64 + dc * 16;
              rv[kq][0] = *(const uint4*)rr;
              rv[kq][1] = *(const uint4*)(rr + 8);
              const float* wp = cw + kk * 192 + part * 64 + dc * 16;
#pragma unroll
              for (int e4 = 0; e4 < 4; ++e4) wv4[kq][e4] = *(const float4*)(wp + e4 * 4);
            }
          }
          __builtin_amdgcn_sched_barrier(0);
#pragma unroll
          for (int kq = 0; kq < 3; ++kq) {
            if (kq < nk) {
              unsigned rw[8] = {rv[kq][0].x, rv[kq][0].y, rv[kq][0].z, rv[kq][0].w, rv[kq][1].x, rv[kq][1].y, rv[kq][1].z, rv[kq][1].w};
#pragma unroll
              for (int e4 = 0; e4 < 4; ++e4) {
                float4 w = wv4[kq][e4];
                acc[e4 * 4 + 0] += w.x * __uint_as_float(rw[e4 * 2] << 16);
                acc[e4 * 4 + 1] += w.y * __uint_as_float(rw[e4 * 2] & 0xffff0000u);
                acc[e4 * 4 + 2] += w.z * __uint_as_float(rw[e4 * 2 + 1] << 16);
                acc[e4 * 4 + 3] += w.w * __uint_as_float(rw[e4 * 2 + 1] & 0xffff0000u);
              }
            }
          }
          __builtin_amdgcn_sched_barrier(0);
        }
        float ss = 0.f;
#pragma unroll
        for (int e = 0; e < 16; ++e) { acc[e] = siluf_(acc[e]); ss += acc[e] * acc[e]; }
        float sc = 1.f;
        if (part < 2) {
          ss += shx(ss, 1, lane);
          ss += shx(ss, 2, lane);
          sc = rsqrtf(ss + 1e-6f) * (part == 0 ? 0.125f : 1.f);
        }
#pragma unroll
        for (int e = 0; e < 16; ++e) acc[e] *= sc;
        u16* dst = (part == 0 ? Qb : (part == 1 ? Kb : Vb)) + ip * 72 + dc * 16;
        *(uint4*)dst = make_uint4(pack2(acc[0], acc[1]), pack2(acc[2], acc[3]), pack2(acc[4], acc[5]), pack2(acc[6], acc[7]));
        *(uint4*)(dst + 8) = make_uint4(pack2(acc[8], acc[9]), pack2(acc[10], acc[11]), pack2(acc[12], acc[13]), pack2(acc[14], acc[15]));
        if (part == 1) {
#pragma unroll
          for (int e = 0; e < 16; ++e) KdT[(dc * 16 + e) * 72 + ip] = f2bf(acc[e] * ekd);
        }
      }
    }
    lds_barrier();
    if (step + 1 < 68) prefetch(step + 1);
    f32x4 rhs[4];
    {
      const int i0 = 16 * wave + fq * 4;
      bf16x8 ka[2], qa[2], kbt[2][4];
      float gi[4], bi[4], gj[4];
      u16 vraw[4][4];
#pragma unroll
      for (int kk = 0; kk < 2; ++kk) {
        ka[kk] = *(const bf16x8*)(Kb + (16 * wave + fr) * 72 + kk * 32 + fq * 8);
        qa[kk] = *(const bf16x8*)(Qb + (16 * wave + fr) * 72 + kk * 32 + fq * 8);
#pragma unroll
        for (int n = 0; n < 4; ++n) kbt[kk][n] = *(const bf16x8*)(Kb + (n * 16 + fr) * 72 + kk * 32 + fq * 8);
      }
      __builtin_amdgcn_sched_barrier(0);
      f32x4 kk4[4], qk[4];
#pragma unroll
      for (int n = 0; n < 4; ++n) {
        kk4[n] = (f32x4){0.f, 0.f, 0.f, 0.f};
        qk[n] = (f32x4){0.f, 0.f, 0.f, 0.f};
        rhs[n] = (f32x4){0.f, 0.f, 0.f, 0.f};
      }
#pragma unroll
      for (int kk = 0; kk < 2; ++kk)
#pragma unroll
        for (int n = 0; n < 4; ++n) {
          kk4[n] = mfma16(ka[kk], kbt[kk][n], kk4[n]);
          qk[n] = mfma16(qa[kk], kbt[kk][n], qk[n]);
        }
      __builtin_amdgcn_sched_barrier(0);
      {
        bf16x8 sbt[2][4];
#pragma unroll
        for (int kk = 0; kk < 2; ++kk)
#pragma unroll
          for (int n = 0; n < 4; ++n) sbt[kk][n] = *(const bf16x8*)(Stb + (n * 16 + fr) * 72 + kk * 32 + fq * 8);
#pragma unroll
        for (int j = 0; j < 4; ++j) { gi[j] = gcs[i0 + j]; bi[j] = bts[i0 + j]; gj[j] = gcs[j * 16 + fr]; }
#pragma unroll
        for (int n = 0; n < 4; ++n)
#pragma unroll
          for (int j = 0; j < 4; ++j) vraw[n][j] = Vb[(i0 + j) * 72 + n * 16 + fr];
        __builtin_amdgcn_sched_barrier(0);
#pragma unroll
        for (int kk = 0; kk < 2; ++kk)
#pragma unroll
          for (int n = 0; n < 4; ++n) rhs[n] = mfma16(ka[kk], sbt[kk][n], rhs[n]);
      }
      float eg[4];
#pragma unroll
      for (int j = 0; j < 4; ++j) eg[j] = __expf(gi[j]);
#pragma unroll
      for (int n = 0; n < 4; ++n) {
        const int jj = n * 16 + fr;
        float lv[4];
#pragma unroll
        for (int j = 0; j < 4; ++j) {
          int i = i0 + j;
          float e = (i >= jj) ? __expf(gi[j] - gj[n]) : 0.f;
          lv[j] = (i > jj) ? bi[j] * kk4[n][j] * e : 0.f;
          Ib[i * 72 + jj] = f2bf(qk[n][j] * e);
          rhs[n][j] = bi[j] * (bf2f(vraw[n][j]) - eg[j] * rhs[n][j]);
        }
        *(float4*)(LfT + jj * 68 + i0) = make_float4(lv[0], lv[1], lv[2], lv[3]);
      }
    }
    lds_barrier();
#pragma unroll
    for (int n = 0; n < 4; ++n)
#pragma unroll
      for (int j = 0; j < 4; ++j) X[(16 * wave + fq * 4 + j) * XS + n * 16 + fr] = rhs[n][j];
    {
      const int c = lane & 15;
      const float* ld = LfT + (16 * wave) * 68 + 16 * wave;
      float x[16];
#pragma unroll
      for (int i = 0; i < 16; ++i) x[i] = (i == c) ? 1.f : 0.f;
#pragma unroll
      for (int hb = 0; hb < 2; ++hb) {
        const int j0 = hb ? 7 : 0, j1 = hb ? 15 : 7;
        float4 lr[8][4];
#pragma unroll
        for (int jq = 0; jq < 8; ++jq) {
          const int j = j0 + jq;
          if (j < j1) {
#pragma unroll
            for (int q4 = 0; q4 < 4; ++q4)
              if (q4 * 4 + 3 > j) lr[jq][q4] = *(const float4*)(ld + j * 68 + q4 * 4);
          }
        }
        __builtin_amdgcn_sched_barrier(0);
#pragma unroll
        for (int jq = 0; jq < 8; ++jq) {
          const int j = j0 + jq;
          if (j < j1) {
            const float xj = x[j];
#pragma unroll
            for (int q4 = 0; q4 < 4; ++q4) {
              if (q4 * 4 + 3 > j) {
                float4 lq = lr[jq][q4];
                if (q4 * 4 + 0 > j) x[q4 * 4 + 0] -= lq.x * xj;
                if (q4 * 4 + 1 > j) x[q4 * 4 + 1] -= lq.y * xj;
                if (q4 * 4 + 2 > j) x[q4 * 4 + 2] -= lq.z * xj;
                if (q4 * 4 + 3 > j) x[q4 * 4 + 3] -= lq.w * xj;
              }
            }
          }
        }
        __builtin_amdgcn_sched_barrier(0);
      }
      if (lane < 16) {
#pragma unroll
        for (int i = 0; i < 16; ++i) Tinv[(wave * 16 + i) * 16 + c] = x[i];
      }
    }
    lds_barrier();
    {
      float* Xw = X + 16 * wave + fr;
      float la[6][4], ta[4][4];
      {
        int bi6 = 0;
#pragma unroll
        for (int r = 1; r < 4; ++r)
#pragma unroll
          for (int c = 0; c < 3; ++c)
            if (c < r) {
#pragma unroll
              for (int k4 = 0; k4 < 4; ++k4) la[bi6][k4] = -LfT[(16 * c + 4 * k4 + fq) * 68 + 16 * r + fr];
              ++bi6;
            }
#pragma unroll
        for (int r = 0; r < 4; ++r)
#pragma unroll
          for (int k4 = 0; k4 < 4; ++k4) ta[r][k4] = Tinv[(r * 16 + fr) * 16 + 4 * k4 + fq];
      }
      int bidx = 0;
#pragma unroll
      for (int r = 0; r < 4; ++r) {
        f32x4 acc;
        float bv[3][4];
#pragma unroll
        for (int j = 0; j < 4; ++j) acc[j] = Xw[(16 * r + fq * 4 + j) * XS];
#pragma unroll
        for (int c = 0; c < 3; ++c)
          if (c < r) {
#pragma unroll
            for (int k4 = 0; k4 < 4; ++k4) bv[c][k4] = Xw[(16 * c + 4 * k4 + fq) * XS];
          }
        __builtin_amdgcn_sched_barrier(0);
#pragma unroll
        for (int c = 0; c < 3; ++c)
          if (c < r) {
#pragma unroll
            for (int k4 = 0; k4 < 4; ++k4) acc = mfma4f(la[bidx][k4], bv[c][k4], acc);
            ++bidx;
          }
#pragma unroll
        for (int j = 0; j < 4; ++j) Xw[(16 * r + fq * 4 + j) * XS] = acc[j];
        float bd[4];
#pragma unroll
        for (int k4 = 0; k4 < 4; ++k4) bd[k4] = Xw[(16 * r + 4 * k4 + fq) * XS];
        f32x4 xr = (f32x4){0.f, 0.f, 0.f, 0.f};
#pragma unroll
        for (int k4 = 0; k4 < 4; ++k4) xr = mfma4f(ta[r][k4], bd[k4], xr);
#pragma unroll
        for (int j = 0; j < 4; ++j) Xw[(16 * r + fq * 4 + j) * XS] = xr[j];
      }
    }
    lds_barrier();
    {
      const int v = tid & 63, ib = (tid >> 6) * 16;
      float xv[16];
#pragma unroll
      for (int ii = 0; ii < 16; ++ii) xv[ii] = X[(ib + ii) * XS + v];
      __builtin_amdgcn_sched_barrier(0);
#pragma unroll
      for (int ii = 0; ii < 16; ii += 2) *(unsigned*)(VnT + v * 72 + ib + ii) = pack2(xv[ii], xv[ii + 1]);
    }
    lds_barrier();
    {
      float ge[4];
#pragma unroll
      for (int j = 0; j < 4; ++j) ge[j] = gcs[16 * wave + fq * 4 + j];
      const float glast = gcs[63];
      if (need_out) {
        f32x4 oo[4];
#pragma unroll
        for (int n = 0; n < 4; ++n) oo[n] = (f32x4){0.f, 0.f, 0.f, 0.f};
        {
          bf16x8 qa[2], sbt[2][4];
#pragma unroll
          for (int kk = 0; kk < 2; ++kk) {
            qa[kk] = *(const bf16x8*)(Qb + (16 * wave + fr) * 72 + kk * 32 + fq * 8);
#pragma unroll
            for (int n = 0; n < 4; ++n) sbt[kk][n] = *(const bf16x8*)(Stb + (n * 16 + fr) * 72 + kk * 32 + fq * 8);
          }
          __builtin_amdgcn_sched_barrier(0);
#pragma unroll
          for (int kk = 0; kk < 2; ++kk)
#pragma unroll
            for (int n = 0; n < 4; ++n) oo[n] = mfma16(qa[kk], sbt[kk][n], oo[n]);
        }
        __builtin_amdgcn_sched_barrier(0);
        {
          bf16x8 ia[2], vbt[2][4];
#pragma unroll
          for (int kk = 0; kk < 2; ++kk) {
            ia[kk] = *(const bf16x8*)(Ib + (16 * wave + fr) * 72 + kk * 32 + fq * 8);
#pragma unroll
            for (int n = 0; n < 4; ++n) vbt[kk][n] = *(const bf16x8*)(VnT + (n * 16 + fr) * 72 + kk * 32 + fq * 8);
          }
          __builtin_amdgcn_sched_barrier(0);
#pragma unroll
          for (int j = 0; j < 4; ++j) {
            float e = __expf(ge[j]);
#pragma unroll
            for (int n = 0; n < 4; ++n) oo[n][j] *= e;
          }
#pragma unroll
          for (int kk = 0; kk < 2; ++kk)
#pragma unroll
            for (int n = 0; n < 4; ++n) oo[n] = mfma16(ia[kk], vbt[kk][n], oo[n]);
        }
#pragma unroll
        for (int n = 0; n < 4; ++n)
#pragma unroll
          for (int j = 0; j < 4; ++j) {
            int i = 16 * wave + fq * 4 + j;
            int tok = tb + (dir ? 63 - i : i);
            Obuf[(gbase + tok) * 384 + h * 64 + n * 16 + fr] = f2bf(oo[n][j]);
          }
        __builtin_amdgcn_sched_barrier(0);
      }
      f32x4 dS[4];
#pragma unroll
      for (int n = 0; n < 4; ++n) dS[n] = (f32x4){0.f, 0.f, 0.f, 0.f};
      {
        bf16x8 va[2], kdt[2][4];
#pragma unroll
        for (int kk = 0; kk < 2; ++kk) {
          va[kk] = *(const bf16x8*)(VnT + (16 * wave + fr) * 72 + kk * 32 + fq * 8);
#pragma unroll
          for (int n = 0; n < 4; ++n) kdt[kk][n] = *(const bf16x8*)(KdT + (n * 16 + fr) * 72 + kk * 32 + fq * 8);
        }
        __builtin_amdgcn_sched_barrier(0);
#pragma unroll
        for (int kk = 0; kk < 2; ++kk)
#pragma unroll
          for (int n = 0; n < 4; ++n) dS[n] = mfma16(va[kk], kdt[kk][n], dS[n]);
      }
      const float dec = __expf(glast);
#pragma unroll
      for (int n = 0; n < 4; ++n)
#pragma unroll
        for (int j = 0; j < 4; ++j) S[n][j] = S[n][j] * dec + dS[n][j];
    }
    lds_barrier();
#pragma unroll
    for (int n = 0; n < 4; ++n)
#pragma unroll
      for (int j = 0; j < 4; ++j) Stb[(16 * wave + fq * 4 + j) * 72 + n * 16 + fr] = f2bf(S[n][j]);
    if (step + 1 < 68) commit();
    lds_barrier();
  }
}

__device__ void phase_mix(const Params& p, int l, char* smem, int* s_item, int cslot, int mask, int wv) {
  int* cnt = (int*)(p.ws + OFF_CNT) + cslot;
  const int n_dn = 192;
  const int n_attn = 3072 + (l < 3 ? 192 : 0);
  const int n_conv = l < 3 ? 2176 : 2048;
  const int total = n_attn + n_conv;
  if ((mask & 1) && (int)blockIdx.x < n_dn) dn_item(p, l, blockIdx.x, smem, wv);
  for (;;) {
    __syncthreads();
    if (opaque_tid(wv) == 0) *s_item = atomicAdd(cnt, 1);
    __syncthreads();
    const int item = *s_item;
    if (item >= total) break;
    if (item < n_attn) { if (mask & 2) attn_item(p, l, item, smem, wv); }
    else { if (mask & 4) conv_item(p, l, item - n_attn, smem, wv); }
  }
}

__device__ void phase_bnorm(const Params& p, int l, int wv) {
  const int tid = opaque_tid(wv);
  const int ntok = l < 3 ? NT : NL;
  const u16* OF = (const u16*)(p.ws + OFF_OF);
  const u16* OB = (const u16*)(p.ws + OFF_OB);
  const u16* P = (const u16*)(p.ws + OFF_P);
  u16* MIX = (u16*)(p.ws + OFF_H);
  const int sub = tid & 15, lane = tid & 63;
  const float4 w = *(const float4*)(p.dn_norm_w + l * 64 + sub * 4);
  const int ngroups = ntok * 6;
  const int gstride = gridDim.x * 16;
  for (int g0 = (blockIdx.x * 256 + tid) >> 4; g0 < ngroups; g0 += gstride * 4) {
    uint2 av[4], bv[4];
    uint2 zv[4];
#pragma unroll
    for (int k = 0; k < 4; ++k) {
      int gidx = g0 + k * gstride;
      if (gidx < ngroups) {
        int tok = gidx / 6, h = gidx % 6;
        av[k] = ld_nt8(OF + (size_t)tok * 384 + h * 64 + sub * 4);
        bv[k] = ld_nt8(OB + (size_t)tok * 384 + h * 64 + sub * 4);
        zv[k] = ld_nt8(P + (size_t)tok * PS + C_ZB + h * 64 + sub * 4);
      } else {
        av[k] = make_uint2(0, 0); bv[k] = av[k]; zv[k] = make_uint2(0, 0);
      }
    }
#pragma unroll
    for (int k = 0; k < 4; ++k) {
      int gidx = g0 + k * gstride;
      float o0 = __uint_as_float(av[k].x << 16) + __uint_as_float(bv[k].x << 16);
      float o1 = __uint_as_float(av[k].x & 0xffff0000u) + __uint_as_float(bv[k].x & 0xffff0000u);
      float o2 = __uint_as_float(av[k].y << 16) + __uint_as_float(bv[k].y << 16);
      float o3 = __uint_as_float(av[k].y & 0xffff0000u) + __uint_as_float(bv[k].y & 0xffff0000u);
      float ss = o0 * o0 + o1 * o1 + o2 * o2 + o3 * o3;
      ss += shx(ss, 1, lane); ss += shx(ss, 2, lane); ss += shx(ss, 4, lane); ss += shx(ss, 8, lane);
      float r = rsqrtf(ss * (1.f / 64.f) + 1e-6f);
      uint2 zz = zv[k];
      float z0 = bf2f((u16)(zz.x & 0xffff)), z1 = bf2f((u16)(zz.x >> 16)), z2 = bf2f((u16)(zz.y & 0xffff)),
            z3 = bf2f((u16)(zz.y >> 16));
      float y0 = o0 * r * w.x * siluf_(z0), y1 = o1 * r * w.y * siluf_(z1), y2 = o2 * r * w.z * siluf_(z2),
            y3 = o3 * r * w.w * siluf_(z3);
      if (gidx < ngroups) {
        int tok = gidx / 6, h = gidx % 6;
        *(uint2*)(MIX + (size_t)tok * 1024 + 256 + h * 64 + sub * 4) = make_uint2(pack2(y0, y1), pack2(y2, y3));
      }
    }
  }
}

__device__ void phase_final(const Params& p, int wv) {
  const int tid = opaque_tid(wv), lane = tid & 63, wave = tid >> 6;
  for (int g = blockIdx.x * 4 + wave; g < NL / 4; g += gridDim.x * 4) {
    float* xr = p.out + (size_t)g * 4 * 1024;
    float4 v[4][4];
#pragma unroll
    for (int rr = 0; rr < 4; ++rr)
#pragma unroll
      for (int i = 0; i < 4; ++i) v[rr][i] = ld_nt16(xr + (size_t)rr * 1024 + (lane + 64 * i) * 4);
    float ss[4];
#pragma unroll
    for (int rr = 0; rr < 4; ++rr) {
      ss[rr] = 0.f;
#pragma unroll
      for (int i = 0; i < 4; ++i)
        ss[rr] += v[rr][i].x * v[rr][i].x + v[rr][i].y * v[rr][i].y + v[rr][i].z * v[rr][i].z + v[rr][i].w * v[rr][i].w;
    }
#pragma unroll
    for (int o = 32; o > 0; o >>= 1) {
#pragma unroll
      for (int rr = 0; rr < 4; ++rr) ss[rr] += shx(ss[rr], o, lane);
    }
#pragma unroll
    for (int i = 0; i < 4; ++i) {
      int c = (lane + 64 * i) * 4;
      float4 w = *(const float4*)(p.final_norm_w + c);
#pragma unroll
      for (int rr = 0; rr < 4; ++rr) {
        float r = rsqrtf(ss[rr] * (1.f / 1024.f) + 1e-6f);
        st_nt16(xr + (size_t)rr * 1024 + c, v[rr][i].x * r * w.x, v[rr][i].y * r * w.y, v[rr][i].z * r * w.z, v[rr][i].w * r * w.w);
      }
    }
  }
}

#define XB_TMO      128
#define XB_XCNT(j)  (256  + 64 * (j))
#define XB_XSUB(j)  (1280 + 64 * (j))
#define XB_XGEN(j)  (2304 + 64 * (j))
#define XB_TOP      3328
#define XB_TOPGEN   3392
#define XCD_BAR_WORDS 3456
#define XB_SPIN_CAP (1u << 18)
#define LAS __attribute__((address_space(3)))
__device__ __forceinline__ unsigned xb_ld(unsigned* p) { return __hip_atomic_load(p, __ATOMIC_RELAXED, __HIP_MEMORY_SCOPE_AGENT); }
__device__ __forceinline__ unsigned xb_add(unsigned* p, unsigned v) { return __hip_atomic_fetch_add(p, v, __ATOMIC_RELAXED, __HIP_MEMORY_SCOPE_AGENT); }
__device__ __forceinline__ unsigned xb_xcc_id() { return (unsigned)__builtin_amdgcn_s_getreg((3 << 11) | 20) & 0xFu; }
#define XB_SPIN(cond, bar) do { unsigned _sp = 0; while (cond) { __builtin_amdgcn_s_sleep(1); \
    if ((++_sp & 255u) == 0u) { if (xb_ld(&(bar)[XB_TMO])) break; if (_sp > XB_SPIN_CAP) { atomicAdd(&(bar)[XB_TMO], 1u); break; } } } } while (0)
struct XcdBarrier { unsigned* bar; unsigned x; volatile LAS unsigned* st; };
__device__ __forceinline__ XcdBarrier xcd_barrier_post(unsigned* bar, volatile LAS unsigned* st, bool t0) {
  XcdBarrier b; b.bar = bar; b.x = xb_xcc_id(); b.st = st;
  if (t0) (void)xb_add(&bar[XB_XCNT(b.x)], 1u);
  return b;
}
__device__ __forceinline__ void xcd_barrier_complete(unsigned* bar, unsigned x, unsigned& nloc, unsigned& nx) {
  const unsigned G = gridDim.x * gridDim.y * gridDim.z;
  unsigned sum, cnt, mine, sp = 0u;
  for (;;) {
    sum = 0u; cnt = 0u; mine = 0u;
#pragma unroll
    for (unsigned j = 0; j < 16; ++j) { const unsigned c = xb_ld(&bar[XB_XCNT(j)]); sum += c; cnt += (c > 0u) ? 1u : 0u; mine = (j == x) ? c : mine; }
    if (sum == G) break;
    __builtin_amdgcn_s_sleep(1);
    if ((++sp & 255u) == 0u) { if (xb_ld(&bar[XB_TMO])) break; if (sp > XB_SPIN_CAP) { atomicAdd(&bar[XB_TMO], 1u); break; } }
  }
  nloc = mine > 0u ? mine : 1u; nx = cnt > 0u ? cnt : 1u;
}
__device__ __forceinline__ void xcd_barrier(const XcdBarrier& b, int wv) {
  asm volatile("s_waitcnt vmcnt(0)" ::: "memory");
  __syncthreads();
  if (opaque_tid(wv) == 0) {
    unsigned* bar = b.bar;
    __builtin_amdgcn_s_waitcnt(0);
    unsigned nloc = b.st[0], nx = b.st[1];
    if (nloc == 0u) { xcd_barrier_complete(bar, b.x, nloc, nx); b.st[0] = nloc; b.st[1] = nx; }
    const unsigned old = xb_add(&bar[XB_XSUB(b.x)], 1u);
    const unsigned gen = old / nloc;
    if (old + 1u == (gen + 1u) * nloc) {
      __builtin_amdgcn_fence(__ATOMIC_RELEASE, "agent");
      asm volatile("s_waitcnt vmcnt(0)" ::: "memory");
      const unsigned og = xb_add(&bar[XB_TOP], 1u);
      const unsigned tg = og / nx;
      if (og + 1u == (tg + 1u) * nx) xb_add(&bar[XB_TOPGEN], 1u);
      else XB_SPIN(xb_ld(&bar[XB_TOPGEN]) == tg, bar);
      __builtin_amdgcn_fence(__ATOMIC_ACQUIRE, "agent");
      xb_add(&bar[XB_XGEN(b.x)], 1u);
      asm volatile("s_waitcnt vmcnt(0)" ::: "memory");
    } else {
      XB_SPIN(xb_ld(&bar[XB_XGEN(b.x)]) == gen, bar);
      __builtin_amdgcn_fence(__ATOMIC_ACQUIRE, "agent");
      asm volatile("s_waitcnt vmcnt(0)" ::: "memory");
    }
  }
  __syncthreads();
}

#define RUNPH(ph) ((ph) >= p.ph_lo && (ph) <= p.ph_hi)
#if MULTI_LAUNCH
#define GSYNC()
#else
#define GSYNC() xcd_barrier(xb, wv)
#endif
__global__ void __launch_bounds__(256, 2) fwd_kernel(Params p) {
  extern __shared__ __attribute__((aligned(16))) char smem[];
  __shared__ uint4 xbw;
  const int wv = __builtin_amdgcn_readfirstlane(threadIdx.x >> 6);
  if (opaque_tid(wv) == 0) xbw = make_uint4(0u, 0u, 0u, 0u);
  __syncthreads();
  int* s_item = (int*)&xbw + 2;
  if (RUNPH(0)) phase_init(p, smem, wv);
#if !MULTI_LAUNCH
  cg::this_grid().sync();
  XcdBarrier xb = xcd_barrier_post((unsigned*)(p.ws + OFF_BAR), (volatile LAS unsigned*)&xbw, opaque_tid(wv) == 0);
#endif
#pragma unroll 1
  for (int l = 0; l < 4; ++l) {
    if (RUNPH(1 + 5 * l)) { phase_norm(p, l, wv); GSYNC(); }
    if (RUNPH(2 + 5 * l)) { phase_gemm<1>(p, l, smem, NT / 256, s_item, wv); GSYNC(); }
    if (RUNPH(3 + 5 * l)) { phase_mix(p, l, smem, s_item, l, 7, wv); GSYNC(); }
    if (RUNPH(4 + 5 * l)) { phase_bnorm(p, l, wv); GSYNC(); }
    if (RUNPH(5 + 5 * l)) { phase_gemm<2>(p, l, smem, (l < 3 ? NT : NL) / 256, s_item, wv); GSYNC(); }
  }
  if (RUNPH(21)) phase_final(p, wv);
}

extern "C" void kernel_launch(void* const* d_in, const int* in_sizes, int n_in, void* d_out, int out_size, void* d_ws,
                              size_t ws_size, hipStream_t stream) {
  static int grid_blocks = 0;
  if (!grid_blocks) {
    int dev = 0, cus = 0, per_cu = 0;
    (void)hipGetDevice(&dev);
    (void)hipDeviceGetAttribute(&cus, hipDeviceAttributeMultiprocessorCount, dev);
    (void)hipFuncSetAttribute((const void*)fwd_kernel, hipFuncAttributeMaxDynamicSharedMemorySize, SMEM_BYTES);
    (void)hipOccupancyMaxActiveBlocksPerMultiprocessor(&per_cu, fwd_kernel, 256, SMEM_BYTES);
    if (per_cu < 1) per_cu = 1;
    grid_blocks = cus * per_cu;
  }
  if (ws_size < WS_END) { fprintf(stderr, "workspace too small: %zu < %zu\n", ws_size, (size_t)WS_END); return; }
  Params p{};
  const float** pp = (const float**)&p;
  for (int i = 0; i < 19; ++i) pp[i] = (const float*)d_in[i];
  p.out = (float*)d_out;
  p.ws = (char*)d_ws;
#if MULTI_LAUNCH
  for (int ph = 0; ph <= 21; ++ph) {
    p.ph_lo = ph; p.ph_hi = ph;
    hipLaunchKernelGGL(fwd_kernel, dim3(grid_blocks), dim3(256), SMEM_BYTES, stream, p);
  }
#else
  p.ph_lo = 0; p.ph_hi = 21;
  void* args[] = {&p};
  hipError_t e = hipLaunchCooperativeKernel((void*)fwd_kernel, dim3(grid_blocks), dim3(256), args, SMEM_BYTES, stream);
  if (e != hipSuccess) fprintf(stderr, "cooperative launch failed: %s (grid %d)\n", hipGetErrorString(e), grid_blocks);
#endif
}
```

```cpp
#include <hip/hip_runtime.h>
#include <hip/hip_bf16.h>
#include <hip/hip_cooperative_groups.h>
#include <cstdio>
namespace cg = cooperative_groups;

typedef __attribute__((ext_vector_type(8))) short bf16x8;
typedef __attribute__((ext_vector_type(4))) float f32x4;
typedef unsigned short u16;

#ifndef PROBE_MASK2
#define PROBE_MASK2 7
#endif
#ifndef PROBE_SYNC
#define PROBE_SYNC 0
#endif
#ifndef PROBE_MIX2
#define PROBE_MIX2 0
#endif
#ifndef PROBE_G1
#define PROBE_G1 0
#endif
#ifndef MIXMASK
#define MIXMASK 7
#endif
#ifndef MULTI_LAUNCH
#define MULTI_LAUNCH 0
#endif

constexpr int NL = 65536;
constexpr int NC = 4096;
constexpr int NT = NL + NC;
constexpr int PS = 3328;
constexpr int NWI = 3456;
constexpr int C_AVAL = 0, C_AGATE = 256, C_ZA = 512, C_QB = 768, C_KB = 1152, C_VB = 1536, C_ZB = 1920;
constexpr int C_QC = 2304, C_KC = 2688, C_VC = 2816, C_ZC = 2944;

constexpr size_t OFF_WI = 0;
constexpr size_t OFF_WO = OFF_WI + (size_t)4 * NWI * 1024 * 2;
constexpr size_t OFF_MOD = OFF_WO + (size_t)4 * 1024 * 1024 * 2;
constexpr size_t OFF_ROPE = OFF_MOD + (size_t)4 * 17 * 3072 * 4;
constexpr size_t OFF_CNT = OFF_ROPE + 64 * 16 * 2 * 4;
constexpr size_t OFF_XC = OFF_CNT + 256;
constexpr size_t OFF_SC = OFF_XC + (size_t)NC * 1024 * 4;
constexpr size_t OFF_P = OFF_SC + (size_t)NT * 32 * 4;
constexpr size_t OFF_H = OFF_P + (size_t)NT * PS * 2;
constexpr size_t OFF_OF = OFF_H + (size_t)NT * 1024 * 2;
constexpr size_t OFF_OB = OFF_OF + (size_t)NT * 384 * 4;
constexpr size_t OFF_BAR = OFF_OB + (size_t)NT * 384 * 4;
constexpr size_t OFF_GQ = OFF_BAR + 3456 * 4;
constexpr size_t WS_END = OFF_GQ + 64 * 4;

constexpr int SMEM_BYTES = 81728;

struct Params {
  const float *x, *c, *ctx, *c_ctx, *norm_w, *ada_w, *ada_b, *w_in, *conv_a_w, *conv_a_b, *ln_a_w, *ln_a_b,
      *qkv_conv_w, *a_log, *dt_bias, *dn_norm_w, *sink, *w_out, *final_norm_w;
  float* out;
  char* ws;
  int ph_lo, ph_hi;
};

__device__ __forceinline__ int opaque_tid(int wv) {
  unsigned m = ~0u;
  asm volatile("" : "+s"(m));
  int lane = __builtin_amdgcn_mbcnt_hi(m, __builtin_amdgcn_mbcnt_lo(m, 0u));
  int t = (wv << 6) | lane;
  asm volatile("" : "+v"(t));
  return t;
}
typedef __bf16 bf2_t __attribute__((ext_vector_type(2)));
typedef float f2_t __attribute__((ext_vector_type(2)));
__device__ __forceinline__ unsigned pack2(float a, float b) {
  f2_t v = {a, b};
  bf2_t r = __builtin_convertvector(v, bf2_t);
  union { bf2_t h; unsigned u; } cv;
  cv.h = r;
  return cv.u;
}
__device__ __forceinline__ u16 f2bf(float f) { return (u16)(pack2(f, 0.f) & 0xffffu); }
typedef float f4nt_t __attribute__((ext_vector_type(4)));
typedef unsigned u2nt_t __attribute__((ext_vector_type(2)));
__device__ __forceinline__ float4 ld_nt16(const float* p) { f4nt_t v = __builtin_nontemporal_load((const f4nt_t*)p); return make_float4(v.x, v.y, v.z, v.w); }
__device__ __forceinline__ uint2 ld_nt8(const u16* p) { u2nt_t v = __builtin_nontemporal_load((const u2nt_t*)p); return make_uint2(v.x, v.y); }
__device__ __forceinline__ void st_nt16(float* p, float a, float b, float c, float d) { f4nt_t v = {a, b, c, d}; __builtin_nontemporal_store(v, (f4nt_t*)p); }
__device__ __forceinline__ float bf2f(u16 h) { return __uint_as_float(((unsigned)h) << 16); }
__device__ __forceinline__ float sigmoidf_(float x) { return __builtin_amdgcn_rcpf(1.f + __expf(-x)); }
__device__ __forceinline__ float siluf_(float x) { return x * __builtin_amdgcn_rcpf(1.f + __expf(-x)); }
__device__ __forceinline__ float shx(float v, int off, int lane) {
  return __int_as_float(__builtin_amdgcn_ds_bpermute((lane ^ off) << 2, __float_as_int(v)));
}
__device__ __forceinline__ float shup(float v, int off, int lane) {
  int src = lane - off;
  src = src < 0 ? lane : src;
  return __int_as_float(__builtin_amdgcn_ds_bpermute(src << 2, __float_as_int(v)));
}
__device__ __forceinline__ float wsum(float v, int lane) {
#pragma unroll
  for (int o = 32; o > 0; o >>= 1) v += shx(v, o, lane);
  return v;
}
__device__ __forceinline__ f32x4 mfma16(bf16x8 a, bf16x8 b, f32x4 c) {
  return __builtin_amdgcn_mfma_f32_16x16x32_bf16(a, b, c, 0, 0, 0);
}
__device__ __forceinline__ void glds16(const void* g, void* l) {
  __builtin_amdgcn_global_load_lds((const __attribute__((address_space(1))) unsigned*)g,
                                   (__attribute__((address_space(3))) unsigned*)l, 16, 0, 0);
}

__device__ void phase_init(const Params& p, char* smem, int wv) {
  const int tid = opaque_tid(wv);
  const size_t gtid = (size_t)blockIdx.x * 256 + tid, gsz = (size_t)gridDim.x * 256;
  int* cnt = (int*)(p.ws + OFF_CNT);
  if (blockIdx.x == 0 && tid < 64) { cnt[tid] = 0; ((int*)(p.ws + OFF_GQ))[tid] = 0; }
  if (blockIdx.x == 0) { unsigned* bw = (unsigned*)(p.ws + OFF_BAR); for (int i = tid; i < 3456; i += 256) bw[i] = 0u; }
  float2* rope = (float2*)(p.ws + OFF_ROPE);
  for (size_t i = gtid; i < 64 * 16; i += gsz) {
    int pos = (int)i / 16, j = (int)i % 16;
    float inv = powf(10000.f, -(float)j / 16.f);
    float a = (float)pos * inv;
    rope[i] = make_float2(cosf(a), sinf(a));
  }
  {
    u16* Wi = (u16*)(p.ws + OFF_WI);
    u16* Wo = (u16*)(p.ws + OFF_WO);
    float* tl = (float*)smem;
    constexpr int NT_WI = 4 * 16 * (NWI / 64);
    for (int t = blockIdx.x; t < NT_WI + 4 * 16 * 16; t += gridDim.x) {
      const bool isWi = t < NT_WI;
      const int tt = isWi ? t : t - NT_WI;
      const int ntn = isWi ? NWI / 64 : 16;
      const int nt = tt % ntn, kt = (tt / ntn) % 16, l = tt / (ntn * 16);
      __syncthreads();
#pragma unroll
      for (int pass = 0; pass < 4; ++pass) {
        const int r = pass * 16 + (tid >> 4), c4 = (tid & 15) * 4;
        const int k = kt * 64 + r, n = nt * 64 + c4;
        float4 v = make_float4(0.f, 0.f, 0.f, 0.f);
        if (isWi) {
          const int glu_src = ((n & 63) < 32 ? 0 : 256 - 32) + (n >> 6) * 32 + (n & 63);
          const int src = n < 512 ? glu_src : (n < 2304 ? n : (n < 3328 ? n + 24 : (n < 3352 ? n - 1024 : -1)));
          if (src >= 0) v = *(const float4*)(p.w_in + ((size_t)l * 1024 + k) * 3352 + src);
        } else {
          v = *(const float4*)(p.w_out + ((size_t)l * 1024 + k) * 1024 + n);
        }
        tl[r * 65 + c4 + 0] = v.x; tl[r * 65 + c4 + 1] = v.y; tl[r * 65 + c4 + 2] = v.z; tl[r * 65 + c4 + 3] = v.w;
      }
      __syncthreads();
      {
        const int n = tid >> 2, kq = tid & 3;
        float f[16];
#pragma unroll
        for (int i = 0; i < 16; ++i) f[i] = tl[(kq * 16 + i) * 65 + n];
        u16* dst = (isWi ? Wi + ((size_t)l * NWI + nt * 64 + n) * 1024 : Wo + ((size_t)l * 1024 + nt * 64 + n) * 1024) + kt * 64 + kq * 16;
        *(uint4*)dst = make_uint4(pack2(f[0], f[1]), pack2(f[2], f[3]), pack2(f[4], f[5]), pack2(f[6], f[7]));
        *(uint4*)(dst + 8) = make_uint4(pack2(f[8], f[9]), pack2(f[10], f[11]), pack2(f[12], f[13]), pack2(f[14], f[15]));
      }
    }
    __syncthreads();
  }
  float* mod = (float*)(p.ws + OFF_MOD);
  float* scond = (float*)smem;
  const int lane = tid & 63, wave = tid >> 6;
  for (int item = blockIdx.x; item < 192; item += gridDim.x) {
    __syncthreads();
    for (int i = tid; i < 17 * 1024; i += 256) {
      int r = i >> 10, k = i & 1023;
      float v = r < 16 ? p.c[r * 1024 + k] : p.c_ctx[k];
      scond[i] = siluf_(v);
    }
    __syncthreads();
    int l = item / 48, j = (item % 48) * 64 + lane;
    float acc[17];
#pragma unroll
    for (int r = 0; r < 17; ++r) acc[r] = 0.f;
    const float* aw = p.ada_w + (size_t)l * 1024 * 3072 + j;
    for (int k4 = 0; k4 < 64; ++k4) {
      int k = wave * 256 + k4 * 4;
      float w0 = aw[(size_t)(k + 0) * 3072], w1 = aw[(size_t)(k + 1) * 3072], w2 = aw[(size_t)(k + 2) * 3072],
            w3 = aw[(size_t)(k + 3) * 3072];
#pragma unroll
      for (int r = 0; r < 17; ++r) {
        float4 s = *(const float4*)(scond + r * 1024 + k);
        acc[r] += s.x * w0 + s.y * w1 + s.z * w2 + s.w * w3;
      }
    }
    __syncthreads();
    float* red = (float*)smem;
#pragma unroll
    for (int r = 0; r < 17; ++r) red[(wave * 17 + r) * 64 + lane] = acc[r];
    __syncthreads();
    for (int i = tid; i < 17 * 64; i += 256) {
      int r = i / 64, jj = i % 64;
      float s = red[(0 * 17 + r) * 64 + jj] + red[(1 * 17 + r) * 64 + jj] + red[(2 * 17 + r) * 64 + jj] +
                red[(3 * 17 + r) * 64 + jj];
      int col = (item % 48) * 64 + jj;
      mod[((size_t)l * 17 + r) * 3072 + col] = s + p.ada_b[l * 3072 + col];
    }
  }
}

__device__ void phase_norm(const Params& p, int l, int wv) {
  const int tid = opaque_tid(wv), lane = tid & 63, wave = tid >> 6;
  const float* xl = l == 0 ? p.x : p.out;
  const float* xc = l == 0 ? p.ctx : (const float*)(p.ws + OFF_XC);
  const float* mod = (const float*)(p.ws + OFF_MOD) + (size_t)l * 17 * 3072;
  const float* nw = p.norm_w + l * 1024;
  u16* H = (u16*)(p.ws + OFF_H);
  for (int g = blockIdx.x * 4 + wave; g < NT / 4; g += gridDim.x * 4) {
    const int row0 = g * 4;
    const float* xr = row0 < NL ? xl + (size_t)row0 * 1024 : xc + (size_t)(row0 - NL) * 1024;
    const float* m = mod + (row0 < NL ? (row0 >> 12) : 16) * 3072;
    float4 v[4][4];
#pragma unroll
    for (int rr = 0; rr < 4; ++rr)
#pragma unroll
      for (int i = 0; i < 4; ++i) v[rr][i] = ld_nt16(xr + (size_t)rr * 1024 + (lane + 64 * i) * 4);
    float ss[4];
#pragma unroll
    for (int rr = 0; rr < 4; ++rr) {
      ss[rr] = 0.f;
#pragma unroll
      for (int i = 0; i < 4; ++i)
        ss[rr] += v[rr][i].x * v[rr][i].x + v[rr][i].y * v[rr][i].y + v[rr][i].z * v[rr][i].z + v[rr][i].w * v[rr][i].w;
    }
#pragma unroll
    for (int o = 32; o > 0; o >>= 1) {
#pragma unroll
      for (int rr = 0; rr < 4; ++rr) ss[rr] += shx(ss[rr], o, lane);
    }
    float r[4];
#pragma unroll
    for (int rr = 0; rr < 4; ++rr) r[rr] = rsqrtf(ss[rr] * (1.f / 1024.f) + 1e-6f);
#pragma unroll
    for (int i = 0; i < 4; ++i) {
      int c = (lane + 64 * i) * 4;
      float4 w = *(const float4*)(nw + c);
      float4 sh = *(const float4*)(m + c);
      float4 sc = *(const float4*)(m + 1024 + c);
      float a0 = w.x * (1.f + sc.x), a1 = w.y * (1.f + sc.y), a2 = w.z * (1.f + sc.z), a3 = w.w * (1.f + sc.w);
#pragma unroll
      for (int rr = 0; rr < 4; ++rr) {
        float h0 = v[rr][i].x * r[rr] * a0 + sh.x;
        float h1 = v[rr][i].y * r[rr] * a1 + sh.y;
        float h2 = v[rr][i].z * r[rr] * a2 + sh.z;
        float h3 = v[rr][i].w * r[rr] * a3 + sh.w;
        *(uint2*)(H + (size_t)(row0 + rr) * 1024 + c) = make_uint2(pack2(h0, h1), pack2(h2, h3));
      }
    }
  }
}

template <int MODE>
__device__ void phase_gemm(const Params& p, int l, char* smem, int mtiles, int* s_item, int wv) {
  const int tid = opaque_tid(wv), lane = tid & 63, wave = tid >> 6;
  const int wr = wave >> 1, wc = wave & 1, fr = lane & 15, fq = lane >> 4;
  const u16* A = (const u16*)(p.ws + OFF_H);
  const u16* Bt = MODE == 1 ? (const u16*)(p.ws + OFF_WI) + (size_t)l * NWI * 1024
                            : (const u16*)(p.ws + OFF_WO) + (size_t)l * 1024 * 1024;
  constexpr int NTN = MODE == 1 ? 27 : 8;
  const int xcd = (int)(((unsigned)__builtin_amdgcn_s_getreg((3 << 11) | 20)) & 7u);
  int* gq = (int*)(p.ws + OFF_GQ) + (l * 2 + (MODE - 1)) * 8;
  const int mp = mtiles >> 3;
  const int per_xcd = mp * NTN;
  for (int s8 = 0; s8 < 8; ++s8) {
  const int stripe = (xcd + s8) & 7;
  for (;;) {
    __syncthreads();
    if (tid == 0) *s_item = atomicAdd(gq + stripe, 1);
    __syncthreads();
    const int u = *s_item;
    if (u >= per_xcd) break;
    constexpr int GP = MODE == 1 ? 3 : 1;
    const int g = u / (GP * NTN);
    const int r = u - g * GP * NTN;
    const int gs = min(GP, mp - g * GP);
    const int tm = stripe * mp + g * GP + r % gs, tn = r / gs;
    const int brow = tm * 256, bcol = tn * 128;
    f32x4 acc[8][4];
#pragma unroll
    for (int m = 0; m < 8; ++m)
#pragma unroll
      for (int n = 0; n < 4; ++n) acc[m][n] = (f32x4){0.f, 0.f, 0.f, 0.f};
    const unsigned voff = (unsigned)(((tid >> 2) * 1024 + ((tid & 3) ^ ((tid >> 4) & 3)) * 8) * 2);
    auto stage = [&](int kt, int buf) {
      char* SA = smem + buf * 24576;
      char* SB = SA + 16384;
      const char* ab = (const char*)A + ((size_t)brow * 1024 + kt * 32) * 2;
      const char* bb = (const char*)Bt + ((size_t)bcol * 1024 + kt * 32) * 2;
#pragma unroll
      for (int i = 0; i < 4; ++i) glds16(ab + (size_t)i * (64 * 2048) + voff, SA + tid * 16 + i * 4096);
#pragma unroll
      for (int i = 0; i < 2; ++i) glds16(bb + (size_t)i * (64 * 2048) + voff, SB + tid * 16 + i * 4096);
    };
    __syncthreads();
    stage(0, 0);
    stage(1, 1);
    int buf = 0;
    for (int kt = 0; kt < 32; ++kt) {
      if (kt < 31) asm volatile("s_waitcnt vmcnt(6)" ::: "memory");
      else asm volatile("s_waitcnt vmcnt(0)" ::: "memory");
      __builtin_amdgcn_s_barrier();
      int nb = buf + 2; nb = nb >= 3 ? nb - 3 : nb;
      if (kt + 2 < 32) stage(kt + 2, nb);
      const char* SA = smem + buf * 24576;
      const char* SB = SA + 16384;
      bf16x8 af[8], bfr[4];
#pragma unroll
      for (int n = 0; n < 4; ++n) bfr[n] = *(const bf16x8*)(SB + (wc * 64 + n * 16 + fr) * 64 + (fq ^ (fr >> 2)) * 16);
#pragma unroll
      for (int m = 0; m < 8; ++m) af[m] = *(const bf16x8*)(SA + (wr * 128 + m * 16 + fr) * 64 + (fq ^ (fr >> 2)) * 16);
      __builtin_amdgcn_sched_barrier(0);
      __builtin_amdgcn_s_setprio(1);
#pragma unroll
      for (int m = 0; m < 8; ++m)
#pragma unroll
        for (int n = 0; n < 4; ++n) acc[m][n] = mfma16(bfr[n], af[m], acc[m][n]);
      __builtin_amdgcn_s_setprio(0);
      buf = buf + 1 == 3 ? 0 : buf + 1;
    }
    int tid_e = tid;
    asm volatile("" : "+v"(tid_e));
    const int fr = tid_e & 15, fq = (tid_e >> 4) & 3, wr = tid_e >> 7, wc = (tid_e >> 6) & 1;
    const int col0 = bcol + wc * 64;
    if (MODE == 1) {
      u16* P = (u16*)(p.ws + OFF_P);
      float* SC = (float*)(p.ws + OFF_SC);
      const float2* rope = (const float2*)(p.ws + OFF_ROPE);
      if (col0 >= 3328) {
        if (col0 == 3328) {
#pragma unroll
          for (int m = 0; m < 8; ++m) {
            int row = brow + wr * 128 + m * 16 + fr;
#pragma unroll
            for (int n = 0; n < 2; ++n)
              *(float4*)(SC + (size_t)row * 32 + n * 16 + fq * 4) =
                  make_float4(acc[m][n][0], acc[m][n][1], acc[m][n][2], acc[m][n][3]);
          }
        }
      } else {
        const bool ropecols = col0 >= C_QC && col0 < C_VC;
        const bool isq = col0 >= C_QC && col0 < C_KC;
#pragma unroll
        for (int m = 0; m < 8; ++m) {
          int row = brow + wr * 128 + m * 16 + fr;
          if (ropecols && row < NL) {
            int tpos = row & 4095;
#pragma unroll
            for (int pr = 0; pr < 2; ++pr) {
              int pos = pr == 0 ? (tpos >> 6) : (tpos & 63);
#pragma unroll
              for (int j = 0; j < 4; ++j) {
                float2 cs = rope[pos * 16 + fq * 4 + j];
                float x1 = acc[m][2 * pr][j], x2 = acc[m][2 * pr + 1][j];
                acc[m][2 * pr][j] = x1 * cs.x - x2 * cs.y;
                acc[m][2 * pr + 1][j] = x2 * cs.x + x1 * cs.y;
              }
            }
          }
          float sc = isq ? 0.125f * 1.44269504088896f : 1.f;
          if (col0 < 512) {
#pragma unroll
            for (int n = 0; n < 2; ++n) {
              *(uint2*)(P + (size_t)row * PS + (col0 >> 1) + n * 16 + fq * 4) =
                  make_uint2(pack2(acc[m][n][0] * sigmoidf_(acc[m][n + 2][0]), acc[m][n][1] * sigmoidf_(acc[m][n + 2][1])),
                             pack2(acc[m][n][2] * sigmoidf_(acc[m][n + 2][2]), acc[m][n][3] * sigmoidf_(acc[m][n + 2][3])));
            }
          } else {
#pragma unroll
          for (int n = 0; n < 4; ++n) {
            *(uint2*)(P + (size_t)row * PS + col0 + n * 16 + fq * 4) =
                make_uint2(pack2(acc[m][n][0] * sc, acc[m][n][1] * sc), pack2(acc[m][n][2] * sc, acc[m][n][3] * sc));
          }
          }
        }
      }
    } else {
      const float* xl = l == 0 ? p.x : p.out;
      const float* xc = l == 0 ? p.ctx : (const float*)(p.ws + OFF_XC);
      float* XC = (float*)(p.ws + OFF_XC);
      const float* mod = (const float*)(p.ws + OFF_MOD) + (size_t)l * 17 * 3072;
#pragma unroll
      for (int m = 0; m < 8; ++m) {
        int row = brow + wr * 128 + m * 16 + fr;
        const float* xo = row < NL ? xl + (size_t)row * 1024 : xc + (size_t)(row - NL) * 1024;
        float* xn = row < NL ? p.out + (size_t)row * 1024 : XC + (size_t)(row - NL) * 1024;
        const float* g = mod + (row < NL ? (row >> 12) : 16) * 3072 + 2048;
#pragma unroll
        for (int n = 0; n < 4; ++n) {
          int c = col0 + n * 16 + fq * 4;
          float4 xv = *(const float4*)(xo + c);
          float4 gv = *(const float4*)(g + c);
          xv.x += gv.x * acc[m][n][0];
          xv.y += gv.y * acc[m][n][1];
          xv.z += gv.z * acc[m][n][2];
          xv.w += gv.w * acc[m][n][3];
          *(float4*)(xn + c) = xv;
        }
      }
    }
  }
  }
}

__device__ void conv_item(const Params& p, int l, int item, char* smem, int wv) {
  float* u = (float*)smem;
  const int tid = opaque_tid(wv), lane = tid & 63, wave = tid >> 6;
  const int g0 = item * 32;
  int s0, s1;
  if (g0 < NL) { s0 = (g0 >> 12) << 12; s1 = s0 + 4096; }
  else { s0 = NL + (((g0 - NL) >> 8) << 8); s1 = s0 + 256; }
  const u16* P = (const u16*)(p.ws + OFF_P);
  {
    uint4 va[8];
#pragma unroll
    for (int q = 0; q < 8; ++q) {
      int idx = tid + 256 * q;
      int r = idx >> 5, c8 = idx & 31;
      int g = g0 - 15 + r;
      va[q] = make_uint4(0, 0, 0, 0);
      if (r < 62 && g >= s0 && g < s1) va[q] = *(const uint4*)(P + (size_t)g * PS + C_AVAL + c8 * 8);
    }
#pragma unroll
    for (int q = 0; q < 8; ++q) {
      int idx = tid + 256 * q;
      int r = idx >> 5, c8 = idx & 31;
      if (r < 62) {
        unsigned aw[4] = {va[q].x, va[q].y, va[q].z, va[q].w};
        *(float4*)(u + r * 256 + c8 * 8) = make_float4(__uint_as_float(aw[0] << 16), __uint_as_float(aw[0] & 0xffff0000u),
                                                       __uint_as_float(aw[1] << 16), __uint_as_float(aw[1] & 0xffff0000u));
        *(float4*)(u + r * 256 + c8 * 8 + 4) = make_float4(__uint_as_float(aw[2] << 16), __uint_as_float(aw[2] & 0xffff0000u),
                                                           __uint_as_float(aw[3] << 16), __uint_as_float(aw[3] & 0xffff0000u));
      }
    }
  }
  __syncthreads();
  float w[31];
#pragma unroll
  for (int k = 0; k < 31; ++k) w[k] = p.conv_a_w[((size_t)l * 31 + k) * 256 + tid];
  const float cb = p.conv_a_b[l * 256 + tid];
#pragma unroll 1
  for (int t0 = 0; t0 < 32; t0 += 8) {
    float uv[38];
#pragma unroll
    for (int i = 0; i < 38; ++i) uv[i] = u[(t0 + i) * 256 + tid];
    __builtin_amdgcn_sched_barrier(0);
    float a[8];
#pragma unroll
    for (int j = 0; j < 8; ++j) a[j] = cb;
#pragma unroll
    for (int k = 0; k < 31; ++k)
#pragma unroll
      for (int j = 0; j < 8; ++j) a[j] += w[k] * uv[j + k];
#pragma unroll
    for (int j = 0; j < 8; ++j) u[(t0 + j) * 256 + tid] = a[j];
  }
  __syncthreads();
  u16* MIX = (u16*)(p.ws + OFF_H);
  const float4 lw = *(const float4*)(p.ln_a_w + l * 256 + lane * 4);
  const float4 lb = *(const float4*)(p.ln_a_b + l * 256 + lane * 4);
  uint2 zzv[8];
#pragma unroll
  for (int tt = 0; tt < 8; ++tt) zzv[tt] = *(const uint2*)(P + (size_t)(g0 + wave * 8 + tt) * PS + C_ZA + lane * 4);
#pragma unroll
  for (int tt = 0; tt < 8; ++tt) {
    int t = wave * 8 + tt;
    float4 v = *(const float4*)(u + t * 256 + lane * 4);
    float mean = wsum(v.x + v.y + v.z + v.w, lane) * (1.f / 256.f);
    float d0 = v.x - mean, d1 = v.y - mean, d2 = v.z - mean, d3 = v.w - mean;
    float var = wsum(d0 * d0 + d1 * d1 + d2 * d2 + d3 * d3, lane) * (1.f / 256.f);
    float rs = rsqrtf(var + 1e-6f);
    size_t row = (size_t)(g0 + t);
    uint2 zz = zzv[tt];
    float z0 = bf2f((u16)(zz.x & 0xffff)), z1 = bf2f((u16)(zz.x >> 16)), z2 = bf2f((u16)(zz.y & 0xffff)),
          z3 = bf2f((u16)(zz.y >> 16));
    float o0 = siluf_(d0 * rs * lw.x + lb.x) * siluf_(z0);
    float o1 = siluf_(d1 * rs * lw.y + lb.y) * siluf_(z1);
    float o2 = siluf_(d2 * rs * lw.z + lb.z) * siluf_(z2);
    float o3 = siluf_(d3 * rs * lw.w + lb.w) * siluf_(z3);
    *(uint2*)(MIX + row * 1024 + lane * 4) = make_uint2(pack2(o0, o1), pack2(o2, o3));
  }
}

__device__ void attn_item(const Params& p, int l, int item, char* smem, int wv) {
  const int tid = opaque_tid(wv), lane = tid & 63, wave = tid >> 6, fr = lane & 15, fq = lane >> 4;
  u16* Ks = (u16*)smem;
  u16* Vt = Ks + 64 * 72;
  const u16* P = (const u16*)(p.ws + OFF_P);
  bool latent;
  int b, qb, head;
  if (item < 3072) { latent = true; b = item / 192; qb = (item / 6) % 32; head = item % 6; }
  else { int it = item - 3072; latent = false; b = it / 12; qb = (it / 6) % 2; head = it % 6; }
  const int kvh = head / 3;
  const size_t qrow0 = (latent ? (size_t)b * 4096 : (size_t)NL + b * 256) + qb * 128 + wave * 32;
  bf16x8 qf[2][2];
#pragma unroll
  for (int qt = 0; qt < 2; ++qt)
#pragma unroll
    for (int ds = 0; ds < 2; ++ds)
      qf[qt][ds] = *(const bf16x8*)(P + (qrow0 + qt * 16 + fr) * PS + C_QC + head * 64 + ds * 32 + fq * 8);
  const float sinkv = p.sink[l * 6 + head] * 1.44269504088896f;
  float mrow[2] = {sinkv, sinkv};
  float lp[2];
  lp[0] = lp[1] = (fq == 0) ? 1.f : 0.f;
  f32x4 o[2][4];
#pragma unroll
  for (int qt = 0; qt < 2; ++qt)
#pragma unroll
    for (int dt = 0; dt < 4; ++dt) o[qt][dt] = (f32x4){0.f, 0.f, 0.f, 0.f};
  const int tlo = latent ? (qb == 0 ? 2 : 0) : 0;
  const int thi = latent ? min(6, 66 - 2 * qb) : 0;
  const int nl = thi - tlo;
  const int ntile = nl + 4;
  const int qw0 = qb * 128 + wave * 32;
  char* stg = (char*)(Vt + 64 * 72);
  auto tile_row0 = [&](int si, bool& local, int& kb0) -> size_t {
    local = si < nl;
    kb0 = local ? qb * 128 - 128 + (tlo + si) * 64 : (si - nl) * 64;
    return local ? (size_t)b * 4096 + kb0 : (size_t)NL + b * 256 + kb0;
  };
  auto prefetch = [&](int si) {
    bool lc; int k0;
    size_t krow0 = tile_row0(si, lc, k0);
#pragma unroll
    for (int rep = 0; rep < 2; ++rep) {
      int idx = tid + rep * 256;
      int key = idx >> 3, s8 = idx & 7;
      glds16(P + (krow0 + key) * PS + C_KC + kvh * 64 + s8 * 8, stg + idx * 16);
      glds16(P + (krow0 + key) * PS + C_VC + kvh * 64 + s8 * 8, stg + 8192 + idx * 16);
    }
  };
  __syncthreads();
  prefetch(0);
  for (int si = 0; si < ntile; ++si) {
    bool local; int kb0;
    tile_row0(si, local, kb0);
    asm volatile("s_waitcnt vmcnt(0)" ::: "memory");
    __syncthreads();
#pragma unroll
    for (int rep = 0; rep < 2; ++rep) {
      int idx = tid + rep * 256;
      int key = idx >> 3, s8 = idx & 7;
      uint4 kv = *(const uint4*)(stg + idx * 16);
      uint4 vv = *(const uint4*)(stg + 8192 + idx * 16);
      *(uint4*)(Ks + key * 72 + s8 * 8) = kv;
      unsigned vw[4] = {vv.x, vv.y, vv.z, vv.w};
#pragma unroll
      for (int e = 0; e < 4; ++e) {
        Vt[(s8 * 8 + 2 * e) * 72 + key] = (u16)(vw[e] & 0xffff);
        Vt[(s8 * 8 + 2 * e + 1) * 72 + key] = (u16)(vw[e] >> 16);
      }
    }
    __syncthreads();
    if (local && (kb0 + 63 < qw0 - 128 || kb0 > qw0 + 31 + 128)) {
      if (si + 1 < ntile) prefetch(si + 1);
      continue;
    }
    bf16x8 kf[4][2];
#pragma unroll
    for (int kt = 0; kt < 4; ++kt)
#pragma unroll
      for (int ds = 0; ds < 2; ++ds) kf[kt][ds] = *(const bf16x8*)(Ks + (kt * 16 + fr) * 72 + ds * 32 + fq * 8);
    bf16x8 vf[4][2];
#pragma unroll
    for (int dt = 0; dt < 4; ++dt)
#pragma unroll
      for (int k2 = 0; k2 < 2; ++k2) {
        uint2 a = *(const uint2*)(Vt + (dt * 16 + fr) * 72 + k2 * 32 + fq * 4);
        uint2 c = *(const uint2*)(Vt + (dt * 16 + fr) * 72 + k2 * 32 + 16 + fq * 4);
        union { uint4 u; bf16x8 v; } cv;
        cv.u = make_uint4(a.x, a.y, c.x, c.y);
        vf[dt][k2] = cv.v;
      }
    __builtin_amdgcn_sched_barrier(0);
    if (si + 1 < ntile) prefetch(si + 1);
    __builtin_amdgcn_sched_barrier(0);
#pragma unroll
    for (int qt = 0; qt < 2; ++qt) {
      f32x4 s[4];
#pragma unroll
      for (int kt = 0; kt < 4; ++kt) {
        s[kt] = (f32x4){0.f, 0.f, 0.f, 0.f};
#pragma unroll
        for (int ds = 0; ds < 2; ++ds) s[kt] = mfma16(kf[kt][ds], qf[qt][ds], s[kt]);
      }
      if (local && !(kb0 >= qw0 + 31 - 128 && kb0 + 63 <= qw0 + 128)) {
        int qpos = qw0 + qt * 16 + fr;
#pragma unroll
        for (int kt = 0; kt < 4; ++kt)
#pragma unroll
          for (int j = 0; j < 4; ++j) {
            int kpos = kb0 + kt * 16 + fq * 4 + j;
            int d = kpos - qpos;
            if (d > 128 || d < -128) s[kt][j] = -INFINITY;
          }
      }
      float mx = -INFINITY;
#pragma unroll
      for (int kt = 0; kt < 4; ++kt)
#pragma unroll
        for (int j = 0; j < 4; ++j) mx = fmaxf(mx, s[kt][j]);
      mx = fmaxf(mx, shx(mx, 16, lane));
      mx = fmaxf(mx, shx(mx, 32, lane));
      float mnew = fmaxf(mrow[qt], mx);
      float alpha = __builtin_amdgcn_exp2f(mrow[qt] - mnew);
      mrow[qt] = mnew;
      float psum = 0.f;
#pragma unroll
      for (int kt = 0; kt < 4; ++kt)
#pragma unroll
        for (int j = 0; j < 4; ++j) {
          float pv = __builtin_amdgcn_exp2f(s[kt][j] - mnew);
          s[kt][j] = pv;
          psum += pv;
        }
      lp[qt] = lp[qt] * alpha + psum;
#pragma unroll
      for (int dt = 0; dt < 4; ++dt) {
        o[qt][dt][0] *= alpha; o[qt][dt][1] *= alpha; o[qt][dt][2] *= alpha; o[qt][dt][3] *= alpha;
      }
#pragma unroll
      for (int k2 = 0; k2 < 2; ++k2) {
        union { uint4 u; bf16x8 v; } pf;
        pf.u = make_uint4(pack2(s[2 * k2][0], s[2 * k2][1]), pack2(s[2 * k2][2], s[2 * k2][3]),
                          pack2(s[2 * k2 + 1][0], s[2 * k2 + 1][1]), pack2(s[2 * k2 + 1][2], s[2 * k2 + 1][3]));
#pragma unroll
        for (int dt = 0; dt < 4; ++dt) o[qt][dt] = mfma16(vf[dt][k2], pf.v, o[qt][dt]);
      }
    }
  }
  u16* MIX = (u16*)(p.ws + OFF_H);
#pragma unroll
  for (int qt = 0; qt < 2; ++qt) {
    float lt = lp[qt];
    lt += shx(lt, 16, lane);
    lt += shx(lt, 32, lane);
    float inv = 1.f / lt;
    size_t row = qrow0 + qt * 16 + fr;
#pragma unroll
    for (int dt = 0; dt < 4; ++dt) {
      int d = dt * 16 + fq * 4;
      uint2 zz = *(const uint2*)(P + row * PS + C_ZC + head * 64 + d);
      float z0 = bf2f((u16)(zz.x & 0xffff)), z1 = bf2f((u16)(zz.x >> 16)), z2 = bf2f((u16)(zz.y & 0xffff)),
            z3 = bf2f((u16)(zz.y >> 16));
      float o0 = o[qt][dt][0] * inv * siluf_(z0);
      float o1 = o[qt][dt][1] * inv * siluf_(z1);
      float o2 = o[qt][dt][2] * inv * siluf_(z2);
      float o3 = o[qt][dt][3] * inv * siluf_(z3);
      *(uint2*)(MIX + row * 1024 + 640 + head * 64 + d) = make_uint2(pack2(o0, o1), pack2(o2, o3));
    }
  }
}

__device__ __forceinline__ void mm64(const u16* A, const u16* Bt, int wave, int fr, int fq, f32x4 acc[4]) {
#pragma unroll
  for (int kk = 0; kk < 2; ++kk) {
    bf16x8 a = *(const bf16x8*)(A + (16 * wave + fr) * 72 + kk * 32 + fq * 8);
#pragma unroll
    for (int n = 0; n < 4; ++n) {
      bf16x8 bb = *(const bf16x8*)(Bt + (n * 16 + fr) * 72 + kk * 32 + fq * 8);
      acc[n] = mfma16(a, bb, acc[n]);
    }
  }
}

__device__ __forceinline__ f32x4 mfma4f(float a, float b, f32x4 c) {
  return __builtin_amdgcn_mfma_f32_16x16x4f32(a, b, c, 0, 0, 0);
}

__device__ __forceinline__ void lds_barrier() {
  asm volatile("s_waitcnt lgkmcnt(0)" ::: "memory");
  __builtin_amdgcn_s_barrier();
  asm volatile("" ::: "memory");
}

__device__ void dn_item(const Params& p, int l, int item, char* smem, int wv) {
  const int tid = opaque_tid(wv), lane = tid & 63, wave = tid >> 6, fr = lane & 15, fq = lane >> 4;
  const int b = item / 12, h = (item / 2) % 6, dir = item & 1;
  constexpr int RS = 200;
  constexpr int XS = 68;
  u16* R0 = (u16*)smem;
  float* LfT = (float*)smem;
  u16* Ib = (u16*)(smem + 17408);
  u16* VnT = (u16*)smem;
  u16* Kb = (u16*)(smem + 27200);
  u16* Vb = Kb + 4608;
  u16* Qb = Vb + 4608;
  float* X = (float*)(smem + 27200);
  u16* KdT = (u16*)(smem + 27200 + 27648);
  u16* Stb = KdT + 4608;
  float* gcs = (float*)(smem + 73280);
  float* bts = gcs + 64;
  float* Tinv = (float*)(smem + 73792);
  float* cw = (float*)(smem + 77888);
  const u16* P = (const u16*)(p.ws + OFF_P);
  const float* SC = (const float*)(p.ws + OFF_SC);
  u16* Obuf = (u16*)(p.ws + (dir ? OFF_OB : OFF_OF));
  const float aexp = expf(p.a_log[l * 12 + dir * 6 + h]);
  const float dtb = p.dt_bias[l * 12 + dir * 6 + h];
  f32x4 S[4];
#pragma unroll
  for (int n = 0; n < 4; ++n) S[n] = (f32x4){0.f, 0.f, 0.f, 0.f};
  __syncthreads();
  for (int i = tid; i < 64 * 72; i += 256) Stb[i] = 0;
  for (int i = tid; i < 960; i += 256) {
    int k = i / 192, c = i % 192, part = c >> 6, d = c & 63;
    cw[i] = p.qkv_conv_w[((size_t)l * 5 + k) * 1152 + part * 384 + h * 64 + d];
  }
  uint4 pre[7];
  float scb = 0.f, scg = 0.f;
  auto chunk_info = [&](int step, size_t& gbase, int& tb, int& Ls) {
    const bool isctx = step < 4;
    const int ci = isctx ? step : step - 4;
    const int nch = isctx ? 4 : 64;
    const int chunk = dir ? nch - 1 - ci : ci;
    Ls = isctx ? 256 : 4096;
    gbase = isctx ? (size_t)NL + b * 256 : (size_t)b * 4096;
    tb = chunk * 64;
  };
  auto prefetch = [&](int step) {
    size_t gbase; int tb, Ls;
    chunk_info(step, gbase, tb, Ls);
    int tl = tid;
    asm volatile("" : "+v"(tl));
    const int rr = tl / 24, seg = tl - rr * 24, part = seg >> 3, s8 = seg & 7;
    const u16* src = P + (gbase + tb - 2 + rr) * PS + C_QB + part * 384 + h * 64 + s8 * 8;
#pragma unroll
    for (int q = 0; q < 7; ++q) {
      int r = rr + 10 * q;
      int t = tb - 2 + r;
      uint4 val = make_uint4(0, 0, 0, 0);
      if (tl < 240 && r < 68 && t >= 0 && t < Ls) val = *(const uint4*)(src + (size_t)(10 * q) * PS);
      pre[q] = val;
    }
    if (wave == 0) {
      int tok = tb + (dir ? 63 - lane : lane);
      const float* sc = SC + (gbase + tok) * 32 + dir * 12;
      scb = sc[h];
      scg = sc[6 + h];
    }
  };
  auto commit = [&]() {
    int tl = tid;
    asm volatile("" : "+v"(tl));
    const int rr = tl / 24, seg = tl - rr * 24, part = seg >> 3, s8 = seg & 7;
#pragma unroll
    for (int q = 0; q < 7; ++q) {
      int r = rr + 10 * q;
      if (tl < 240 && r < 68) *(uint4*)(R0 + r * RS + part * 64 + s8 * 8) = pre[q];
    }
    if (wave == 0) {
      float bet = sigmoidf_(scb);
      float xx = scg + dtb;
      float ex = __expf(xx);
      float sp = xx > 20.f ? xx : (ex < 0.01f ? ex * (1.f - ex * (0.5f - ex * (1.f / 3.f))) : __logf(1.f + ex));
      float g = -aexp * sp;
#pragma unroll
      for (int off = 1; off < 64; off <<= 1) {
        float tv = shup(g, off, lane);
        if (lane >= off) g += tv;
      }
      gcs[lane] = g;
      bts[lane] = bet;
    }
  };
  prefetch(0);
  commit();
  __syncthreads();

  for (int step = 0; step < 68; ++step) {
    size_t gbase; int tb, Ls;
    chunk_info(step, gbase, tb, Ls);
    const bool need_out = (step >= 4) || (l < 3);
    {
      const int ti = tid >> 2, dc = tid & 3;
      const int ip = dir ? 63 - ti : ti;
      const float ekd = __expf(gcs[63] - gcs[ip]);
#pragma unroll
      for (int part = 0; part < 3; ++part) {
        float acc[16];
#pragma unroll
        for (int e = 0; e < 16; ++e) acc[e] = 0.f;
#pragma unroll
        for (int kb2 = 0; kb2 < 2; ++kb2) {
          const int k0 = kb2 * 3, nk = kb2 ? 2 : 3;
          uint4 rv[3][2];
          float4 wv4[3][4];
#pragma unroll
          for (int kq = 0; kq < 3; ++kq) {
            if (kq < nk) {
              const int kk = k0 + kq;
              const u16* rr = R0 + (ti + kk) * RS + part * 64 + dc * 16;
              rv[kq][0] = *(const uint4*)rr;
              rv[kq][1] = *(const uint4*)(rr + 8);
              const float* wp = cw + kk * 192 + part * 64 + dc * 16;
#pragma unroll
              for (int e4 = 0; e4 < 4; ++e4) wv4[kq][e4] = *(const float4*)(wp + e4 * 4);
            }
          }
          __builtin_amdgcn_sched_barrier(0);
#pragma unroll
          for (int kq = 0; kq < 3; ++kq) {
            if (kq < nk) {
              unsigned rw[8] = {rv[kq][0].x, rv[kq][0].y, rv[kq][0].z, rv[kq][0].w, rv[kq][1].x, rv[kq][1].y, rv[kq][1].z, rv[kq][1].w};
#pragma unroll
              for (int e4 = 0; e4 < 4; ++e4) {
                float4 w = wv4[kq][e4];
                acc[e4 * 4 + 0] += w.x * __uint_as_float(rw[e4 * 2] << 16);
                acc[e4 * 4 + 1] += w.y * __uint_as_float(rw[e4 * 2] & 0xffff0000u);
                acc[e4 * 4 + 2] += w.z * __uint_as_float(rw[e4 * 2 + 1] << 16);
                acc[e4 * 4 + 3] += w.w * __uint_as_float(rw[e4 * 2 + 1] & 0xffff0000u);
              }
            }
          }
          __builtin_amdgcn_sched_barrier(0);
        }
        float ss = 0.f;
#pragma unroll
        for (int e = 0; e < 16; ++e) { acc[e] = siluf_(acc[e]); ss += acc[e] * acc[e]; }
        float sc = 1.f;
        if (part < 2) {
          ss += shx(ss, 1, lane);
          ss += shx(ss, 2, lane);
          sc = rsqrtf(ss + 1e-6f) * (part == 0 ? 0.125f : 1.f);
        }
#pragma unroll
        for (int e = 0; e < 16; ++e) acc[e] *= sc;
        u16* dst = (part == 0 ? Qb : (part == 1 ? Kb : Vb)) + ip * 72 + dc * 16;
        *(uint4*)dst = make_uint4(pack2(acc[0], acc[1]), pack2(acc[2], acc[3]), pack2(acc[4], acc[5]), pack2(acc[6], acc[7]));
        *(uint4*)(dst + 8) = make_uint4(pack2(acc[8], acc[9]), pack2(acc[10], acc[11]), pack2(acc[12], acc[13]), pack2(acc[14], acc[15]));
        if (part == 1) {
#pragma unroll
          for (int e = 0; e < 16; ++e) KdT[(dc * 16 + e) * 72 + ip] = f2bf(acc[e] * ekd);
        }
      }
    }
    lds_barrier();
    if (step + 1 < 68) prefetch(step + 1);
    f32x4 rhs[4];
    {
      const int i0 = 16 * wave + fq * 4;
      bf16x8 ka[2], qa[2], kbt[2][4];
      float gi[4], bi[4], gj[4];
      u16 vraw[4][4];
#pragma unroll
      for (int kk = 0; kk < 2; ++kk) {
        ka[kk] = *(const bf16x8*)(Kb + (16 * wave + fr) * 72 + kk * 32 + fq * 8);
        qa[kk] = *(const bf16x8*)(Qb + (16 * wave + fr) * 72 + kk * 32 + fq * 8);
#pragma unroll
        for (int n = 0; n < 4; ++n) kbt[kk][n] = *(const bf16x8*)(Kb + (n * 16 + fr) * 72 + kk * 32 + fq * 8);
      }
      __builtin_amdgcn_sched_barrier(0);
      f32x4 kk4[4], qk[4];
#pragma unroll
      for (int n = 0; n < 4; ++n) {
        kk4[n] = (f32x4){0.f, 0.f, 0.f, 0.f};
        qk[n] = (f32x4){0.f, 0.f, 0.f, 0.f};
        rhs[n] = (f32x4){0.f, 0.f, 0.f, 0.f};
      }
#pragma unroll
      for (int kk = 0; kk < 2; ++kk)
#pragma unroll
        for (int n = 0; n < 4; ++n) {
          kk4[n] = mfma16(ka[kk], kbt[kk][n], kk4[n]);
          qk[n] = mfma16(qa[kk], kbt[kk][n], qk[n]);
        }
      __builtin_amdgcn_sched_barrier(0);
      {
        bf16x8 sbt[2][4];
#pragma unroll
        for (int kk = 0; kk < 2; ++kk)
#pragma unroll
          for (int n = 0; n < 4; ++n) sbt[kk][n] = *(const bf16x8*)(Stb + (n * 16 + fr) * 72 + kk * 32 + fq * 8);
#pragma unroll
        for (int j = 0; j < 4; ++j) { gi[j] = gcs[i0 + j]; bi[j] = bts[i0 + j]; gj[j] = gcs[j * 16 + fr]; }
#pragma unroll
        for (int n = 0; n < 4; ++n)
#pragma unroll
          for (int j = 0; j < 4; ++j) vraw[n][j] = Vb[(i0 + j) * 72 + n * 16 + fr];
        __builtin_amdgcn_sched_barrier(0);
#pragma unroll
        for (int kk = 0; kk < 2; ++kk)
#pragma unroll
          for (int n = 0; n < 4; ++n) rhs[n] = mfma16(ka[kk], sbt[kk][n], rhs[n]);
      }
      float eg[4];
#pragma unroll
      for (int j = 0; j < 4; ++j) eg[j] = __expf(gi[j]);
#pragma unroll
      for (int n = 0; n < 4; ++n) {
        const int jj = n * 16 + fr;
        float lv[4];
#pragma unroll
        for (int j = 0; j < 4; ++j) {
          int i = i0 + j;
          float e = (i >= jj) ? __expf(gi[j] - gj[n]) : 0.f;
          lv[j] = (i > jj) ? bi[j] * kk4[n][j] * e : 0.f;
          Ib[i * 72 + jj] = f2bf(qk[n][j] * e);
          rhs[n][j] = bi[j] * (bf2f(vraw[n][j]) - eg[j] * rhs[n][j]);
        }
        *(float4*)(LfT + jj * 68 + i0) = make_float4(lv[0], lv[1], lv[2], lv[3]);
      }
    }
    lds_barrier();
#pragma unroll
    for (int n = 0; n < 4; ++n)
#pragma unroll
      for (int j = 0; j < 4; ++j) X[(16 * wave + fq * 4 + j) * XS + n * 16 + fr] = rhs[n][j];
    {
      const int c = lane & 15;
      const float* ld = LfT + (16 * wave) * 68 + 16 * wave;
      float x[16];
#pragma unroll
      for (int i = 0; i < 16; ++i) x[i] = (i == c) ? 1.f : 0.f;
#pragma unroll
      for (int hb = 0; hb < 2; ++hb) {
        const int j0 = hb ? 7 : 0, j1 = hb ? 15 : 7;
        float4 lr[8][4];
#pragma unroll
        for (int jq = 0; jq < 8; ++jq) {
          const int j = j0 + jq;
          if (j < j1) {
#pragma unroll
            for (int q4 = 0; q4 < 4; ++q4)
              if (q4 * 4 + 3 > j) lr[jq][q4] = *(const float4*)(ld + j * 68 + q4 * 4);
          }
        }
        __builtin_amdgcn_sched_barrier(0);
#pragma unroll
        for (int jq = 0; jq < 8; ++jq) {
          const int j = j0 + jq;
          if (j < j1) {
            const float xj = x[j];
#pragma unroll
            for (int q4 = 0; q4 < 4; ++q4) {
              if (q4 * 4 + 3 > j) {
                float4 lq = lr[jq][q4];
                if (q4 * 4 + 0 > j) x[q4 * 4 + 0] -= lq.x * xj;
                if (q4 * 4 + 1 > j) x[q4 * 4 + 1] -= lq.y * xj;
                if (q4 * 4 + 2 > j) x[q4 * 4 + 2] -= lq.z * xj;
                if (q4 * 4 + 3 > j) x[q4 * 4 + 3] -= lq.w * xj;
              }
            }
          }
        }
        __builtin_amdgcn_sched_barrier(0);
      }
      if (lane < 16) {
#pragma unroll
        for (int i = 0; i < 16; ++i) Tinv[(wave * 16 + i) * 16 + c] = x[i];
      }
    }
    lds_barrier();
    {
      float* Xw = X + 16 * wave + fr;
      float la[6][4], ta[4][4];
      {
        int bi6 = 0;
#pragma unroll
        for (int r = 1; r < 4; ++r)
#pragma unroll
          for (int c = 0; c < 3; ++c)
            if (c < r) {
#pragma unroll
              for (int k4 = 0; k4 < 4; ++k4) la[bi6][k4] = -LfT[(16 * c + 4 * k4 + fq) * 68 + 16 * r + fr];
              ++bi6;
            }
#pragma unroll
        for (int r = 0; r < 4; ++r)
#pragma unroll
          for (int k4 = 0; k4 < 4; ++k4) ta[r][k4] = Tinv[(r * 16 + fr) * 16 + 4 * k4 + fq];
      }
      int bidx = 0;
#pragma unroll
      for (int r = 0; r < 4; ++r) {
        f32x4 acc;
        float bv[3][4];
#pragma unroll
        for (int j = 0; j < 4; ++j) acc[j] = Xw[(16 * r + fq * 4 + j) * XS];
#pragma unroll
        for (int c = 0; c < 3; ++c)
          if (c < r) {
#pragma unroll
            for (int k4 = 0; k4 < 4; ++k4) bv[c][k4] = Xw[(16 * c + 4 * k4 + fq) * XS];
          }
        __builtin_amdgcn_sched_barrier(0);
#pragma unroll
        for (int c = 0; c < 3; ++c)
          if (c < r) {
#pragma unroll
            for (int k4 = 0; k4 < 4; ++k4) acc = mfma4f(la[bidx][k4], bv[c][k4], acc);
            ++bidx;
          }
#pragma unroll
        for (int j = 0; j < 4; ++j) Xw[(16 * r + fq * 4 + j) * XS] = acc[j];
        float bd[4];
#pragma unroll
        for (int k4 = 0; k4 < 4; ++k4) bd[k4] = Xw[(16 * r + 4 * k4 + fq) * XS];
        f32x4 xr = (f32x4){0.f, 0.f, 0.f, 0.f};
#pragma unroll
        for (int k4 = 0; k4 < 4; ++k4) xr = mfma4f(ta[r][k4], bd[k4], xr);
#pragma unroll
        for (int j = 0; j < 4; ++j) Xw[(16 * r + fq * 4 + j) * XS] = xr[j];
      }
    }
    lds_barrier();
    {
      const int v = tid & 63, ib = (tid >> 6) * 16;
      float xv[16];
#pragma unroll
      for (int ii = 0; ii < 16; ++ii) xv[ii] = X[(ib + ii) * XS + v];
      __builtin_amdgcn_sched_barrier(0);
#pragma unroll
      for (int ii = 0; ii < 16; ii += 2) *(unsigned*)(VnT + v * 72 + ib + ii) = pack2(xv[ii], xv[ii + 1]);
    }
    lds_barrier();
    {
      float ge[4];
#pragma unroll
      for (int j = 0; j < 4; ++j) ge[j] = gcs[16 * wave + fq * 4 + j];
      const float glast = gcs[63];
      if (need_out) {
        f32x4 oo[4];
#pragma unroll
        for (int n = 0; n < 4; ++n) oo[n] = (f32x4){0.f, 0.f, 0.f, 0.f};
        {
          bf16x8 qa[2], sbt[2][4];
#pragma unroll
          for (int kk = 0; kk < 2; ++kk) {
            qa[kk] = *(const bf16x8*)(Qb + (16 * wave + fr) * 72 + kk * 32 + fq * 8);
#pragma unroll
            for (int n = 0; n < 4; ++n) sbt[kk][n] = *(const bf16x8*)(Stb + (n * 16 + fr) * 72 + kk * 32 + fq * 8);
          }
          __builtin_amdgcn_sched_barrier(0);
#pragma unroll
          for (int kk = 0; kk < 2; ++kk)
#pragma unroll
            for (int n = 0; n < 4; ++n) oo[n] = mfma16(qa[kk], sbt[kk][n], oo[n]);
        }
        __builtin_amdgcn_sched_barrier(0);
        {
          bf16x8 ia[2], vbt[2][4];
#pragma unroll
          for (int kk = 0; kk < 2; ++kk) {
            ia[kk] = *(const bf16x8*)(Ib + (16 * wave + fr) * 72 + kk * 32 + fq * 8);
#pragma unroll
            for (int n = 0; n < 4; ++n) vbt[kk][n] = *(const bf16x8*)(VnT + (n * 16 + fr) * 72 + kk * 32 + fq * 8);
          }
          __builtin_amdgcn_sched_barrier(0);
#pragma unroll
          for (int j = 0; j < 4; ++j) {
            float e = __expf(ge[j]);
#pragma unroll
            for (int n = 0; n < 4; ++n) oo[n][j] *= e;
          }
#pragma unroll
          for (int kk = 0; kk < 2; ++kk)
#pragma unroll
            for (int n = 0; n < 4; ++n) oo[n] = mfma16(ia[kk], vbt[kk][n], oo[n]);
        }
#pragma unroll
        for (int n = 0; n < 4; ++n)
#pragma unroll
          for (int j = 0; j < 4; ++j) {
            int i = 16 * wave + fq * 4 + j;
            int tok = tb + (dir ? 63 - i : i);
            Obuf[(gbase + tok) * 384 + h * 64 + n * 16 + fr] = f2bf(oo[n][j]);
          }
        __builtin_amdgcn_sched_barrier(0);
      }
      f32x4 dS[4];
#pragma unroll
      for (int n = 0; n < 4; ++n) dS[n] = (f32x4){0.f, 0.f, 0.f, 0.f};
      {
        bf16x8 va[2], kdt[2][4];
#pragma unroll
        for (int kk = 0; kk < 2; ++kk) {
          va[kk] = *(const bf16x8*)(VnT + (16 * wave + fr) * 72 + kk * 32 + fq * 8);
#pragma unroll
          for (int n = 0; n < 4; ++n) kdt[kk][n] = *(const bf16x8*)(KdT + (n * 16 + fr) * 72 + kk * 32 + fq * 8);
        }
        __builtin_amdgcn_sched_barrier(0);
#pragma unroll
        for (int kk = 0; kk < 2; ++kk)
#pragma unroll
          for (int n = 0; n < 4; ++n) dS[n] = mfma16(va[kk], kdt[kk][n], dS[n]);
      }
      const float dec = __expf(glast);
#pragma unroll
      for (int n = 0; n < 4; ++n)
#pragma unroll
        for (int j = 0; j < 4; ++j) S[n][j] = S[n][j] * dec + dS[n][j];
    }
    lds_barrier();
#pragma unroll
    for (int n = 0; n < 4; ++n)
#pragma unroll
      for (int j = 0; j < 4; ++j) Stb[(16 * wave + fq * 4 + j) * 72 + n * 16 + fr] = f2bf(S[n][j]);
    if (step + 1 < 68) commit();
    lds_barrier();
  }
}

__device__ void phase_mix(const Params& p, int l, char* smem, int* s_item, int cslot, int mask, int wv) {
  int* cnt = (int*)(p.ws + OFF_CNT) + cslot;
  const int n_dn = 192;
  const int n_attn = 3072 + (l < 3 ? 192 : 0);
  const int n_conv = l < 3 ? 2176 : 2048;
  const int total = n_attn + n_conv;
  if ((mask & 1) && (int)blockIdx.x < n_dn) dn_item(p, l, blockIdx.x, smem, wv);
  for (;;) {
    __syncthreads();
    if (opaque_tid(wv) == 0) *s_item = atomicAdd(cnt, 1);
    __syncthreads();
    const int item = *s_item;
    if (item >= total) break;
    if (item < n_attn) { if (mask & 2) attn_item(p, l, item, smem, wv); }
    else { if (mask & 4) conv_item(p, l, item - n_attn, smem, wv); }
  }
}

__device__ void phase_bnorm(const Params& p, int l, int wv) {
  const int tid = opaque_tid(wv);
  const int ntok = l < 3 ? NT : NL;
  const u16* OF = (const u16*)(p.ws + OFF_OF);
  const u16* OB = (const u16*)(p.ws + OFF_OB);
  const u16* P = (const u16*)(p.ws + OFF_P);
  u16* MIX = (u16*)(p.ws + OFF_H);
  const int sub = tid & 15, lane = tid & 63;
  const float4 w = *(const float4*)(p.dn_norm_w + l * 64 + sub * 4);
  const int ngroups = ntok * 6;
  const int gstride = gridDim.x * 16;
  for (int g0 = (blockIdx.x * 256 + tid) >> 4; g0 < ngroups; g0 += gstride * 4) {
    uint2 av[4], bv[4];
    uint2 zv[4];
#pragma unroll
    for (int k = 0; k < 4; ++k) {
      int gidx = g0 + k * gstride;
      if (gidx < ngroups) {
        int tok = gidx / 6, h = gidx % 6;
        av[k] = ld_nt8(OF + (size_t)tok * 384 + h * 64 + sub * 4);
        bv[k] = ld_nt8(OB + (size_t)tok * 384 + h * 64 + sub * 4);
        zv[k] = *(const uint2*)(P + (size_t)tok * PS + C_ZB + h * 64 + sub * 4);
      } else {
        av[k] = make_uint2(0, 0); bv[k] = av[k]; zv[k] = make_uint2(0, 0);
      }
    }
#pragma unroll
    for (int k = 0; k < 4; ++k) {
      int gidx = g0 + k * gstride;
      float o0 = __uint_as_float(av[k].x << 16) + __uint_as_float(bv[k].x << 16);
      float o1 = __uint_as_float(av[k].x & 0xffff0000u) + __uint_as_float(bv[k].x & 0xffff0000u);
      float o2 = __uint_as_float(av[k].y << 16) + __uint_as_float(bv[k].y << 16);
      float o3 = __uint_as_float(av[k].y & 0xffff0000u) + __uint_as_float(bv[k].y & 0xffff0000u);
      float ss = o0 * o0 + o1 * o1 + o2 * o2 + o3 * o3;
      ss += shx(ss, 1, lane); ss += shx(ss, 2, lane); ss += shx(ss, 4, lane); ss += shx(ss, 8, lane);
      float r = rsqrtf(ss * (1.f / 64.f) + 1e-6f);
      uint2 zz = zv[k];
      float z0 = bf2f((u16)(zz.x & 0xffff)), z1 = bf2f((u16)(zz.x >> 16)), z2 = bf2f((u16)(zz.y & 0xffff)),
            z3 = bf2f((u16)(zz.y >> 16));
      float y0 = o0 * r * w.x * siluf_(z0), y1 = o1 * r * w.y * siluf_(z1), y2 = o2 * r * w.z * siluf_(z2),
            y3 = o3 * r * w.w * siluf_(z3);
      if (gidx < ngroups) {
        int tok = gidx / 6, h = gidx % 6;
        *(uint2*)(MIX + (size_t)tok * 1024 + 256 + h * 64 + sub * 4) = make_uint2(pack2(y0, y1), pack2(y2, y3));
      }
    }
  }
}

__device__ void phase_final(const Params& p, int wv) {
  const int tid = opaque_tid(wv), lane = tid & 63, wave = tid >> 6;
  for (int g = blockIdx.x * 4 + wave; g < NL / 4; g += gridDim.x * 4) {
    float* xr = p.out + (size_t)g * 4 * 1024;
    float4 v[4][4];
#pragma unroll
    for (int rr = 0; rr < 4; ++rr)
#pragma unroll
      for (int i = 0; i < 4; ++i) v[rr][i] = ld_nt16(xr + (size_t)rr * 1024 + (lane + 64 * i) * 4);
    float ss[4];
#pragma unroll
    for (int rr = 0; rr < 4; ++rr) {
      ss[rr] = 0.f;
#pragma unroll
      for (int i = 0; i < 4; ++i)
        ss[rr] += v[rr][i].x * v[rr][i].x + v[rr][i].y * v[rr][i].y + v[rr][i].z * v[rr][i].z + v[rr][i].w * v[rr][i].w;
    }
#pragma unroll
    for (int o = 32; o > 0; o >>= 1) {
#pragma unroll
      for (int rr = 0; rr < 4; ++rr) ss[rr] += shx(ss[rr], o, lane);
    }
#pragma unroll
    for (int i = 0; i < 4; ++i) {
      int c = (lane + 64 * i) * 4;
      float4 w = *(const float4*)(p.final_norm_w + c);
#pragma unroll
      for (int rr = 0; rr < 4; ++rr) {
        float r = rsqrtf(ss[rr] * (1.f / 1024.f) + 1e-6f);
        st_nt16(xr + (size_t)rr * 1024 + c, v[rr][i].x * r * w.x, v[rr][i].y * r * w.y, v[rr][i].z * r * w.z, v[rr][i].w * r * w.w);
      }
    }
  }
}

#define XB_TMO      128
#define XB_XCNT(j)  (256  + 64 * (j))
#define XB_XSUB(j)  (1280 + 64 * (j))
#define XB_XGEN(j)  (2304 + 64 * (j))
#define XB_TOP      3328
#define XB_TOPGEN   3392
#define XCD_BAR_WORDS 3456
#define XB_SPIN_CAP (1u << 18)
#define LAS __attribute__((address_space(3)))
__device__ __forceinline__ unsigned xb_ld(unsigned* p) { return __hip_atomic_load(p, __ATOMIC_RELAXED, __HIP_MEMORY_SCOPE_AGENT); }
__device__ __forceinline__ unsigned xb_add(unsigned* p, unsigned v) { return __hip_atomic_fetch_add(p, v, __ATOMIC_RELAXED, __HIP_MEMORY_SCOPE_AGENT); }
__device__ __forceinline__ unsigned xb_xcc_id() { return (unsigned)__builtin_amdgcn_s_getreg((3 << 11) | 20) & 0xFu; }
#define XB_SPIN(cond, bar) do { unsigned _sp = 0; while (cond) { __builtin_amdgcn_s_sleep(1); \
    if ((++_sp & 255u) == 0u) { if (xb_ld(&(bar)[XB_TMO])) break; if (_sp > XB_SPIN_CAP) { atomicAdd(&(bar)[XB_TMO], 1u); break; } } } } while (0)
struct XcdBarrier { unsigned* bar; unsigned x; volatile LAS unsigned* st; };
__device__ __forceinline__ XcdBarrier xcd_barrier_post(unsigned* bar, volatile LAS unsigned* st, bool t0) {
  XcdBarrier b; b.bar = bar; b.x = xb_xcc_id(); b.st = st;
  if (t0) (void)xb_add(&bar[XB_XCNT(b.x)], 1u);
  return b;
}
__device__ __forceinline__ void xcd_barrier_complete(unsigned* bar, unsigned x, unsigned& nloc, unsigned& nx) {
  const unsigned G = gridDim.x * gridDim.y * gridDim.z;
  unsigned sum, cnt, mine, sp = 0u;
  for (;;) {
    sum = 0u; cnt = 0u; mine = 0u;
#pragma unroll
    for (unsigned j = 0; j < 16; ++j) { const unsigned c = xb_ld(&bar[XB_XCNT(j)]); sum += c; cnt += (c > 0u) ? 1u : 0u; mine = (j == x) ? c : mine; }
    if (sum == G) break;
    __builtin_amdgcn_s_sleep(1);
    if ((++sp & 255u) == 0u) { if (xb_ld(&bar[XB_TMO])) break; if (sp > XB_SPIN_CAP) { atomicAdd(&bar[XB_TMO], 1u); break; } }
  }
  nloc = mine > 0u ? mine : 1u; nx = cnt > 0u ? cnt : 1u;
}
__device__ __forceinline__ void xcd_barrier(const XcdBarrier& b, int wv) {
  asm volatile("s_waitcnt vmcnt(0)" ::: "memory");
  __syncthreads();
  if (opaque_tid(wv) == 0) {
    unsigned* bar = b.bar;
    __builtin_amdgcn_s_waitcnt(0);
    unsigned nloc = b.st[0], nx = b.st[1];
    if (nloc == 0u) { xcd_barrier_complete(bar, b.x, nloc, nx); b.st[0] = nloc; b.st[1] = nx; }
    const unsigned old = xb_add(&bar[XB_XSUB(b.x)], 1u);
    const unsigned gen = old / nloc;
    if (old + 1u == (gen + 1u) * nloc) {
      __builtin_amdgcn_fence(__ATOMIC_RELEASE, "agent");
      asm volatile("s_waitcnt vmcnt(0)" ::: "memory");
      const unsigned og = xb_add(&bar[XB_TOP], 1u);
      const unsigned tg = og / nx;
      if (og + 1u == (tg + 1u) * nx) xb_add(&bar[XB_TOPGEN], 1u);
      else XB_SPIN(xb_ld(&bar[XB_TOPGEN]) == tg, bar);
      __builtin_amdgcn_fence(__ATOMIC_ACQUIRE, "agent");
      xb_add(&bar[XB_XGEN(b.x)], 1u);
      asm volatile("s_waitcnt vmcnt(0)" ::: "memory");
    } else {
      XB_SPIN(xb_ld(&bar[XB_XGEN(b.x)]) == gen, bar);
      __builtin_amdgcn_fence(__ATOMIC_ACQUIRE, "agent");
      asm volatile("s_waitcnt vmcnt(0)" ::: "memory");
    }
  }
  __syncthreads();
}

#define RUNPH(ph) ((ph) >= p.ph_lo && (ph) <= p.ph_hi)
#if MULTI_LAUNCH
#define GSYNC()
#else
#define GSYNC() xcd_barrier(xb, wv)
#endif
__global__ void __launch_bounds__(256, 2) fwd_kernel(Params p) {
  extern __shared__ __attribute__((aligned(16))) char smem[];
  __shared__ uint4 xbw;
  const int wv = __builtin_amdgcn_readfirstlane(threadIdx.x >> 6);
  if (opaque_tid(wv) == 0) xbw = make_uint4(0u, 0u, 0u, 0u);
  __syncthreads();
  int* s_item = (int*)&xbw + 2;
  if (RUNPH(0)) phase_init(p, smem, wv);
#if !MULTI_LAUNCH
  cg::this_grid().sync();
  XcdBarrier xb = xcd_barrier_post((unsigned*)(p.ws + OFF_BAR), (volatile LAS unsigned*)&xbw, opaque_tid(wv) == 0);
#endif
#pragma unroll 1
  for (int l = 0; l < 4; ++l) {
    if (RUNPH(1 + 5 * l)) { phase_norm(p, l, wv); GSYNC(); }
    if (RUNPH(2 + 5 * l)) { phase_gemm<1>(p, l, smem, NT / 256, s_item, wv); GSYNC(); }
    if (RUNPH(3 + 5 * l)) { phase_mix(p, l, smem, s_item, l, 7, wv); GSYNC(); }
    if (RUNPH(4 + 5 * l)) { phase_bnorm(p, l, wv); GSYNC(); }
    if (RUNPH(5 + 5 * l)) { phase_gemm<2>(p, l, smem, (l < 3 ? NT : NL) / 256, s_item, wv); GSYNC(); }
  }
  if (RUNPH(21)) phase_final(p, wv);
}

extern "C" void kernel_launch(void* const* d_in, const int* in_sizes, int n_in, void* d_out, int out_size, void* d_ws,
                              size_t ws_size, hipStream_t stream) {
  static int grid_blocks = 0;
  if (!grid_blocks) {
    int dev = 0, cus = 0, per_cu = 0;
    (void)hipGetDevice(&dev);
    (void)hipDeviceGetAttribute(&cus, hipDeviceAttributeMultiprocessorCount, dev);
    (void)hipFuncSetAttribute((const void*)fwd_kernel, hipFuncAttributeMaxDynamicSharedMemorySize, SMEM_BYTES);
    (void)hipOccupancyMaxActiveBlocksPerMultiprocessor(&per_cu, fwd_kernel, 256, SMEM_BYTES);
    if (per_cu < 1) per_cu = 1;
    grid_blocks = cus * per_cu;
  }
  if (ws_size < WS_END) { fprintf(stderr, "workspace too small: %zu < %zu\n", ws_size, (size_t)WS_END); return; }
  Params p{};
  const float** pp = (const float**)&p;
  for (int i = 0; i < 19; ++i) pp[i] = (const float*)d_in[i];
  p.out = (float*)d_out;
  p.ws = (char*)d_ws;
#if MULTI_LAUNCH
  for (int ph = 0; ph <= 21; ++ph) {
    p.ph_lo = ph; p.ph_hi = ph;
    hipLaunchKernelGGL(fwd_kernel, dim3(grid_blocks), dim3(256), SMEM_BYTES, stream, p);
  }
#else
  p.ph_lo = 0; p.ph_hi = 21;
  void* args[] = {&p};
  hipError_t e = hipLaunchCooperativeKernel((void*)fwd_kernel, dim3(grid_blocks), dim3(256), args, SMEM_BYTES, stream);
  if (e != hipSuccess) fprintf(stderr, "cooperative launch failed: %s (grid %d)\n", hipGetErrorString(e), grid_blocks);
#endif
}
```

```cpp
#include <hip/hip_runtime.h>
#include <hip/hip_bf16.h>
#include <hip/hip_cooperative_groups.h>
#include <cstdio>
namespace cg = cooperative_groups;

typedef __attribute__((ext_vector_type(8))) short bf16x8;
typedef __attribute__((ext_vector_type(4))) float f32x4;
typedef unsigned short u16;

#ifndef PROBE_MASK2
#define PROBE_MASK2 7
#endif
#ifndef PROBE_SYNC
#define PROBE_SYNC 0
#endif
#ifndef PROBE_MIX2
#define PROBE_MIX2 0
#endif
#ifndef PROBE_G1
#define PROBE_G1 0
#endif
#ifndef MIXMASK
#define MIXMASK 7
#endif
#ifndef MULTI_LAUNCH
#define MULTI_LAUNCH 0
#endif

constexpr int NL = 65536;
constexpr int NC = 4096;
constexpr int NT = NL + NC;
constexpr int PS = 3328;
constexpr int NWI = 3456;
constexpr int C_AVAL = 0, C_AGATE = 256, C_ZA = 512, C_QB = 768, C_KB = 1152, C_VB = 1536, C_ZB = 1920;
constexpr int C_QC = 2304, C_KC = 2688, C_VC = 2816, C_ZC = 2944;

constexpr size_t OFF_WI = 0;
constexpr size_t OFF_WO = OFF_WI + (size_t)4 * NWI * 1024 * 2;
constexpr size_t OFF_MOD = OFF_WO + (size_t)4 * 1024 * 1024 * 2;
constexpr size_t OFF_ROPE = OFF_MOD + (size_t)4 * 17 * 3072 * 4;
constexpr size_t OFF_CNT = OFF_ROPE + 64 * 16 * 2 * 4;
constexpr size_t OFF_XC = OFF_CNT + 256;
constexpr size_t OFF_SC = OFF_XC + (size_t)NC * 1024 * 4;
constexpr size_t OFF_P = OFF_SC + (size_t)NT * 32 * 4;
constexpr size_t OFF_H = OFF_P + (size_t)NT * PS * 2;
constexpr size_t OFF_OF = OFF_H + (size_t)NT * 1024 * 2;
constexpr size_t OFF_OB = OFF_OF + (size_t)NT * 384 * 4;
constexpr size_t OFF_BAR = OFF_OB + (size_t)NT * 384 * 4;
constexpr size_t OFF_GQ = OFF_BAR + 3456 * 4;
constexpr size_t WS_END = OFF_GQ + 64 * 4;

constexpr int SMEM_BYTES = 81728;

struct Params {
  const float *x, *c, *ctx, *c_ctx, *norm_w, *ada_w, *ada_b, *w_in, *conv_a_w, *conv_a_b, *ln_a_w, *ln_a_b,
      *qkv_conv_w, *a_log, *dt_bias, *dn_norm_w, *sink, *w_out, *final_norm_w;
  float* out;
  char* ws;
  int ph_lo, ph_hi;
};

__device__ __forceinline__ int opaque_tid(int wv) {
  unsigned m = ~0u;
  asm volatile("" : "+s"(m));
  int lane = __builtin_amdgcn_mbcnt_hi(m, __builtin_amdgcn_mbcnt_lo(m, 0u));
  int t = (wv << 6) | lane;
  asm volatile("" : "+v"(t));
  return t;
}
typedef __bf16 bf2_t __attribute__((ext_vector_type(2)));
typedef float f2_t __attribute__((ext_vector_type(2)));
__device__ __forceinline__ unsigned pack2(float a, float b) {
  f2_t v = {a, b};
  bf2_t r = __builtin_convertvector(v, bf2_t);
  union { bf2_t h; unsigned u; } cv;
  cv.h = r;
  return cv.u;
}
__device__ __forceinline__ u16 f2bf(float f) { return (u16)(pack2(f, 0.f) & 0xffffu); }
typedef float f4nt_t __attribute__((ext_vector_type(4)));
typedef unsigned u2nt_t __attribute__((ext_vector_type(2)));
__device__ __forceinline__ float4 ld_nt16(const float* p) { f4nt_t v = __builtin_nontemporal_load((const f4nt_t*)p); return make_float4(v.x, v.y, v.z, v.w); }
__device__ __forceinline__ uint2 ld_nt8(const u16* p) { u2nt_t v = __builtin_nontemporal_load((const u2nt_t*)p); return make_uint2(v.x, v.y); }
__device__ __forceinline__ void st_nt16(float* p, float a, float b, float c, float d) { f4nt_t v = {a, b, c, d}; __builtin_nontemporal_store(v, (f4nt_t*)p); }
__device__ __forceinline__ float bf2f(u16 h) { return __uint_as_float(((unsigned)h) << 16); }
__device__ __forceinline__ float sigmoidf_(float x) { return __builtin_amdgcn_rcpf(1.f + __expf(-x)); }
__device__ __forceinline__ float siluf_(float x) { return x * __builtin_amdgcn_rcpf(1.f + __expf(-x)); }
__device__ __forceinline__ float shx(float v, int off, int lane) {
  return __int_as_float(__builtin_amdgcn_ds_bpermute((lane ^ off) << 2, __float_as_int(v)));
}
__device__ __forceinline__ float shup(float v, int off, int lane) {
  int src = lane - off;
  src = src < 0 ? lane : src;
  return __int_as_float(__builtin_amdgcn_ds_bpermute(src << 2, __float_as_int(v)));
}
__device__ __forceinline__ float wsum(float v, int lane) {
#pragma unroll
  for (int o = 32; o > 0; o >>= 1) v += shx(v, o, lane);
  return v;
}
__device__ __forceinline__ f32x4 mfma16(bf16x8 a, bf16x8 b, f32x4 c) {
  return __builtin_amdgcn_mfma_f32_16x16x32_bf16(a, b, c, 0, 0, 0);
}
__device__ __forceinline__ void glds16(const void* g, void* l) {
  __builtin_amdgcn_global_load_lds((const __attribute__((address_space(1))) unsigned*)g,
                                   (__attribute__((address_space(3))) unsigned*)l, 16, 0, 0);
}

__device__ void phase_init(const Params& p, char* smem, int wv) {
  const int tid = opaque_tid(wv);
  const size_t gtid = (size_t)blockIdx.x * 256 + tid, gsz = (size_t)gridDim.x * 256;
  int* cnt = (int*)(p.ws + OFF_CNT);
  if (blockIdx.x == 0 && tid < 64) { cnt[tid] = 0; ((int*)(p.ws + OFF_GQ))[tid] = 0; }
  if (blockIdx.x == 0) { unsigned* bw = (unsigned*)(p.ws + OFF_BAR); for (int i = tid; i < 3456; i += 256) bw[i] = 0u; }
  float2* rope = (float2*)(p.ws + OFF_ROPE);
  for (size_t i = gtid; i < 64 * 16; i += gsz) {
    int pos = (int)i / 16, j = (int)i % 16;
    float inv = powf(10000.f, -(float)j / 16.f);
    float a = (float)pos * inv;
    rope[i] = make_float2(cosf(a), sinf(a));
  }
  {
    u16* Wi = (u16*)(p.ws + OFF_WI);
    u16* Wo = (u16*)(p.ws + OFF_WO);
    float* tl = (float*)smem;
    constexpr int NT_WI = 4 * 16 * (NWI / 64);
    for (int t = blockIdx.x; t < NT_WI + 4 * 16 * 16; t += gridDim.x) {
      const bool isWi = t < NT_WI;
      const int tt = isWi ? t : t - NT_WI;
      const int ntn = isWi ? NWI / 64 : 16;
      const int nt = tt % ntn, kt = (tt / ntn) % 16, l = tt / (ntn * 16);
      __syncthreads();
#pragma unroll
      for (int pass = 0; pass < 4; ++pass) {
        const int r = pass * 16 + (tid >> 4), c4 = (tid & 15) * 4;
        const int k = kt * 64 + r, n = nt * 64 + c4;
        float4 v = make_float4(0.f, 0.f, 0.f, 0.f);
        if (isWi) {
          const int glu_src = ((n & 63) < 32 ? 0 : 256 - 32) + (n >> 6) * 32 + (n & 63);
          const int src = n < 512 ? glu_src : (n < 2304 ? n : (n < 3328 ? n + 24 : (n < 3352 ? n - 1024 : -1)));
          if (src >= 0) v = *(const float4*)(p.w_in + ((size_t)l * 1024 + k) * 3352 + src);
        } else {
          v = *(const float4*)(p.w_out + ((size_t)l * 1024 + k) * 1024 + n);
        }
        tl[r * 65 + c4 + 0] = v.x; tl[r * 65 + c4 + 1] = v.y; tl[r * 65 + c4 + 2] = v.z; tl[r * 65 + c4 + 3] = v.w;
      }
      __syncthreads();
      {
        const int n = tid >> 2, kq = tid & 3;
        float f[16];
#pragma unroll
        for (int i = 0; i < 16; ++i) f[i] = tl[(kq * 16 + i) * 65 + n];
        u16* dst = (isWi ? Wi + ((size_t)l * NWI + nt * 64 + n) * 1024 : Wo + ((size_t)l * 1024 + nt * 64 + n) * 1024) + kt * 64 + kq * 16;
        *(uint4*)dst = make_uint4(pack2(f[0], f[1]), pack2(f[2], f[3]), pack2(f[4], f[5]), pack2(f[6], f[7]));
        *(uint4*)(dst + 8) = make_uint4(pack2(f[8], f[9]), pack2(f[10], f[11]), pack2(f[12], f[13]), pack2(f[14], f[15]));
      }
    }
    __syncthreads();
  }
  float* mod = (float*)(p.ws + OFF_MOD);
  float* scond = (float*)smem;
  const int lane = tid & 63, wave = tid >> 6;
  for (int item = blockIdx.x; item < 192; item += gridDim.x) {
    __syncthreads();
    for (int i = tid; i < 17 * 1024; i += 256) {
      int r = i >> 10, k = i & 1023;
      float v = r < 16 ? p.c[r * 1024 + k] : p.c_ctx[k];
      scond[i] = siluf_(v);
    }
    __syncthreads();
    int l = item / 48, j = (item % 48) * 64 + lane;
    float acc[17];
#pragma unroll
    for (int r = 0; r < 17; ++r) acc[r] = 0.f;
    const float* aw = p.ada_w + (size_t)l * 1024 * 3072 + j;
    for (int k4 = 0; k4 < 64; ++k4) {
      int k = wave * 256 + k4 * 4;
      float w0 = aw[(size_t)(k + 0) * 3072], w1 = aw[(size_t)(k + 1) * 3072], w2 = aw[(size_t)(k + 2) * 3072],
            w3 = aw[(size_t)(k + 3) * 3072];
#pragma unroll
      for (int r = 0; r < 17; ++r) {
        float4 s = *(const float4*)(scond + r * 1024 + k);
        acc[r] += s.x * w0 + s.y * w1 + s.z * w2 + s.w * w3;
      }
    }
    __syncthreads();
    float* red = (float*)smem;
#pragma unroll
    for (int r = 0; r < 17; ++r) red[(wave * 17 + r) * 64 + lane] = acc[r];
    __syncthreads();
    for (int i = tid; i < 17 * 64; i += 256) {
      int r = i / 64, jj = i % 64;
      float s = red[(0 * 17 + r) * 64 + jj] + red[(1 * 17 + r) * 64 + jj] + red[(2 * 17 + r) * 64 + jj] +
                red[(3 * 17 + r) * 64 + jj];
      int col = (item % 48) * 64 + jj;
      mod[((size_t)l * 17 + r) * 3072 + col] = s + p.ada_b[l * 3072 + col];
    }
  }
}

__device__ void phase_norm(const Params& p, int l, int wv) {
  const int tid = opaque_tid(wv), lane = tid & 63, wave = tid >> 6;
  const float* xl = l == 0 ? p.x : p.out;
  const float* xc = l == 0 ? p.ctx : (const float*)(p.ws + OFF_XC);
  const float* mod = (const float*)(p.ws + OFF_MOD) + (size_t)l * 17 * 3072;
  const float* nw = p.norm_w + l * 1024;
  u16* H = (u16*)(p.ws + OFF_H);
  for (int g = blockIdx.x * 4 + wave; g < NT / 4; g += gridDim.x * 4) {
    const int row0 = g * 4;
    const float* xr = row0 < NL ? xl + (size_t)row0 * 1024 : xc + (size_t)(row0 - NL) * 1024;
    const float* m = mod + (row0 < NL ? (row0 >> 12) : 16) * 3072;
    float4 v[4][4];
#pragma unroll
    for (int rr = 0; rr < 4; ++rr)
#pragma unroll
      for (int i = 0; i < 4; ++i) v[rr][i] = ld_nt16(xr + (size_t)rr * 1024 + (lane + 64 * i) * 4);
    float ss[4];
#pragma unroll
    for (int rr = 0; rr < 4; ++rr) {
      ss[rr] = 0.f;
#pragma unroll
      for (int i = 0; i < 4; ++i)
        ss[rr] += v[rr][i].x * v[rr][i].x + v[rr][i].y * v[rr][i].y + v[rr][i].z * v[rr][i].z + v[rr][i].w * v[rr][i].w;
    }
#pragma unroll
    for (int o = 32; o > 0; o >>= 1) {
#pragma unroll
      for (int rr = 0; rr < 4; ++rr) ss[rr] += shx(ss[rr], o, lane);
    }
    float r[4];
#pragma unroll
    for (int rr = 0; rr < 4; ++rr) r[rr] = rsqrtf(ss[rr] * (1.f / 1024.f) + 1e-6f);
#pragma unroll
    for (int i = 0; i < 4; ++i) {
      int c = (lane + 64 * i) * 4;
      float4 w = *(const float4*)(nw + c);
      float4 sh = *(const float4*)(m + c);
      float4 sc = *(const float4*)(m + 1024 + c);
      float a0 = w.x * (1.f + sc.x), a1 = w.y * (1.f + sc.y), a2 = w.z * (1.f + sc.z), a3 = w.w * (1.f + sc.w);
#pragma unroll
      for (int rr = 0; rr < 4; ++rr) {
        float h0 = v[rr][i].x * r[rr] * a0 + sh.x;
        float h1 = v[rr][i].y * r[rr] * a1 + sh.y;
        float h2 = v[rr][i].z * r[rr] * a2 + sh.z;
        float h3 = v[rr][i].w * r[rr] * a3 + sh.w;
        *(uint2*)(H + (size_t)(row0 + rr) * 1024 + c) = make_uint2(pack2(h0, h1), pack2(h2, h3));
      }
    }
  }
}

template <int MODE>
__device__ void phase_gemm(const Params& p, int l, char* smem, int mtiles, int* s_item, int wv) {
  const int tid = opaque_tid(wv), lane = tid & 63, wave = tid >> 6;
  const int wr = wave >> 1, wc = wave & 1, fr = lane & 15, fq = lane >> 4;
  const u16* A = (const u16*)(p.ws + OFF_H);
  const u16* Bt = MODE == 1 ? (const u16*)(p.ws + OFF_WI) + (size_t)l * NWI * 1024
                            : (const u16*)(p.ws + OFF_WO) + (size_t)l * 1024 * 1024;
  constexpr int NTN = MODE == 1 ? 27 : 8;
  const int xcd = (int)(((unsigned)__builtin_amdgcn_s_getreg((3 << 11) | 20)) & 7u);
  int* gq = (int*)(p.ws + OFF_GQ) + (l * 2 + (MODE - 1)) * 8;
  const int mp = mtiles >> 3;
  const int per_xcd = mp * NTN;
  for (int s8 = 0; s8 < 8; ++s8) {
  const int stripe = (xcd + s8) & 7;
  for (;;) {
    __syncthreads();
    if (tid == 0) *s_item = atomicAdd(gq + stripe, 1);
    __syncthreads();
    const int u = *s_item;
    if (u >= per_xcd) break;
    constexpr int GP = MODE == 1 ? 3 : 1;
    const int g = u / (GP * NTN);
    const int r = u - g * GP * NTN;
    const int gs = min(GP, mp - g * GP);
    const int tm = stripe * mp + g * GP + r % gs, tn = r / gs;
    if (MODE == 1 && l == 3 && tm >= NL / 256 && !((tn >= 6 && tn <= 14) || tn == 21 || tn == 22 || tn == 26)) continue;
    const int brow = tm * 256, bcol = tn * 128;
    f32x4 acc[8][4];
#pragma unroll
    for (int m = 0; m < 8; ++m)
#pragma unroll
      for (int n = 0; n < 4; ++n) acc[m][n] = (f32x4){0.f, 0.f, 0.f, 0.f};
    const unsigned voff = (unsigned)(((tid >> 2) * 1024 + ((tid & 3) ^ ((tid >> 4) & 3)) * 8) * 2);
    auto stage = [&](int kt, int buf) {
      char* SA = smem + buf * 24576;
      char* SB = SA + 16384;
      const char* ab = (const char*)A + ((size_t)brow * 1024 + kt * 32) * 2;
      const char* bb = (const char*)Bt + ((size_t)bcol * 1024 + kt * 32) * 2;
#pragma unroll
      for (int i = 0; i < 4; ++i) glds16(ab + (size_t)i * (64 * 2048) + voff, SA + tid * 16 + i * 4096);
#pragma unroll
      for (int i = 0; i < 2; ++i) glds16(bb + (size_t)i * (64 * 2048) + voff, SB + tid * 16 + i * 4096);
    };
    __syncthreads();
    stage(0, 0);
    stage(1, 1);
    int buf = 0;
    for (int kt = 0; kt < 32; ++kt) {
      if (kt < 31) asm volatile("s_waitcnt vmcnt(6)" ::: "memory");
      else asm volatile("s_waitcnt vmcnt(0)" ::: "memory");
      __builtin_amdgcn_s_barrier();
      int nb = buf + 2; nb = nb >= 3 ? nb - 3 : nb;
      if (kt + 2 < 32) stage(kt + 2, nb);
      const char* SA = smem + buf * 24576;
      const char* SB = SA + 16384;
      bf16x8 af[8], bfr[4];
#pragma unroll
      for (int n = 0; n < 4; ++n) bfr[n] = *(const bf16x8*)(SB + (wc * 64 + n * 16 + fr) * 64 + (fq ^ (fr >> 2)) * 16);
#pragma unroll
      for (int m = 0; m < 8; ++m) af[m] = *(const bf16x8*)(SA + (wr * 128 + m * 16 + fr) * 64 + (fq ^ (fr >> 2)) * 16);
      __builtin_amdgcn_sched_barrier(0);
      __builtin_amdgcn_s_setprio(1);
#pragma unroll
      for (int m = 0; m < 8; ++m)
#pragma unroll
        for (int n = 0; n < 4; ++n) acc[m][n] = mfma16(bfr[n], af[m], acc[m][n]);
      __builtin_amdgcn_s_setprio(0);
      buf = buf + 1 == 3 ? 0 : buf + 1;
    }
    int tid_e = tid;
    asm volatile("" : "+v"(tid_e));
    const int fr = tid_e & 15, fq = (tid_e >> 4) & 3, wr = tid_e >> 7, wc = (tid_e >> 6) & 1;
    const int col0 = bcol + wc * 64;
    if (MODE == 1) {
      u16* P = (u16*)(p.ws + OFF_P);
      float* SC = (float*)(p.ws + OFF_SC);
      const float2* rope = (const float2*)(p.ws + OFF_ROPE);
      if (col0 >= 3328) {
        if (col0 == 3328) {
#pragma unroll
          for (int m = 0; m < 8; ++m) {
            int row = brow + wr * 128 + m * 16 + fr;
#pragma unroll
            for (int n = 0; n < 2; ++n)
              *(float4*)(SC + (size_t)row * 32 + n * 16 + fq * 4) =
                  make_float4(acc[m][n][0], acc[m][n][1], acc[m][n][2], acc[m][n][3]);
          }
        }
      } else {
        const bool ropecols = col0 >= C_QC && col0 < C_VC;
        const bool isq = col0 >= C_QC && col0 < C_KC;
#pragma unroll
        for (int m = 0; m < 8; ++m) {
          int row = brow + wr * 128 + m * 16 + fr;
          if (ropecols && row < NL) {
            int tpos = row & 4095;
#pragma unroll
            for (int pr = 0; pr < 2; ++pr) {
              int pos = pr == 0 ? (tpos >> 6) : (tpos & 63);
#pragma unroll
              for (int j = 0; j < 4; ++j) {
                float2 cs = rope[pos * 16 + fq * 4 + j];
                float x1 = acc[m][2 * pr][j], x2 = acc[m][2 * pr + 1][j];
                acc[m][2 * pr][j] = x1 * cs.x - x2 * cs.y;
                acc[m][2 * pr + 1][j] = x2 * cs.x + x1 * cs.y;
              }
            }
          }
          float sc = isq ? 0.125f * 1.44269504088896f : 1.f;
          if (col0 < 512) {
#pragma unroll
            for (int n = 0; n < 2; ++n) {
              *(uint2*)(P + (size_t)row * PS + (col0 >> 1) + n * 16 + fq * 4) =
                  make_uint2(pack2(acc[m][n][0] * sigmoidf_(acc[m][n + 2][0]), acc[m][n][1] * sigmoidf_(acc[m][n + 2][1])),
                             pack2(acc[m][n][2] * sigmoidf_(acc[m][n + 2][2]), acc[m][n][3] * sigmoidf_(acc[m][n + 2][3])));
            }
          } else {
#pragma unroll
          for (int n = 0; n < 4; ++n) {
            *(uint2*)(P + (size_t)row * PS + col0 + n * 16 + fq * 4) =
                make_uint2(pack2(acc[m][n][0] * sc, acc[m][n][1] * sc), pack2(acc[m][n][2] * sc, acc[m][n][3] * sc));
          }
          }
        }
      }
    } else {
      const float* xl = l == 0 ? p.x : p.out;
      const float* xc = l == 0 ? p.ctx : (const float*)(p.ws + OFF_XC);
      float* XC = (float*)(p.ws + OFF_XC);
      const float* mod = (const float*)(p.ws + OFF_MOD) + (size_t)l * 17 * 3072;
#pragma unroll
      for (int m = 0; m < 8; ++m) {
        int row = brow + wr * 128 + m * 16 + fr;
        const float* xo = row < NL ? xl + (size_t)row * 1024 : xc + (size_t)(row - NL) * 1024;
        float* xn = row < NL ? p.out + (size_t)row * 1024 : XC + (size_t)(row - NL) * 1024;
        const float* g = mod + (row < NL ? (row >> 12) : 16) * 3072 + 2048;
#pragma unroll
        for (int n = 0; n < 4; ++n) {
          int c = col0 + n * 16 + fq * 4;
          float4 xv = *(const float4*)(xo + c);
          float4 gv = *(const float4*)(g + c);
          xv.x += gv.x * acc[m][n][0];
          xv.y += gv.y * acc[m][n][1];
          xv.z += gv.z * acc[m][n][2];
          xv.w += gv.w * acc[m][n][3];
          *(float4*)(xn + c) = xv;
        }
      }
    }
  }
  }
}

__device__ void conv_item(const Params& p, int l, int item, char* smem, int wv) {
  float* u = (float*)smem;
  const int tid = opaque_tid(wv), lane = tid & 63, wave = tid >> 6;
  const int g0 = item * 32;
  int s0, s1;
  if (g0 < NL) { s0 = (g0 >> 12) << 12; s1 = s0 + 4096; }
  else { s0 = NL + (((g0 - NL) >> 8) << 8); s1 = s0 + 256; }
  const u16* P = (const u16*)(p.ws + OFF_P);
  {
    uint4 va[8];
#pragma unroll
    for (int q = 0; q < 8; ++q) {
      int idx = tid + 256 * q;
      int r = idx >> 5, c8 = idx & 31;
      int g = g0 - 15 + r;
      va[q] = make_uint4(0, 0, 0, 0);
      if (r < 62 && g >= s0 && g < s1) va[q] = *(const uint4*)(P + (size_t)g * PS + C_AVAL + c8 * 8);
    }
#pragma unroll
    for (int q = 0; q < 8; ++q) {
      int idx = tid + 256 * q;
      int r = idx >> 5, c8 = idx & 31;
      if (r < 62) {
        unsigned aw[4] = {va[q].x, va[q].y, va[q].z, va[q].w};
        *(float4*)(u + r * 256 + c8 * 8) = make_float4(__uint_as_float(aw[0] << 16), __uint_as_float(aw[0] & 0xffff0000u),
                                                       __uint_as_float(aw[1] << 16), __uint_as_float(aw[1] & 0xffff0000u));
        *(float4*)(u + r * 256 + c8 * 8 + 4) = make_float4(__uint_as_float(aw[2] << 16), __uint_as_float(aw[2] & 0xffff0000u),
                                                           __uint_as_float(aw[3] << 16), __uint_as_float(aw[3] & 0xffff0000u));
      }
    }
  }
  __syncthreads();
  float w[31];
#pragma unroll
  for (int k = 0; k < 31; ++k) w[k] = p.conv_a_w[((size_t)l * 31 + k) * 256 + tid];
  const float cb = p.conv_a_b[l * 256 + tid];
#pragma unroll 1
  for (int t0 = 0; t0 < 32; t0 += 8) {
    float uv[38];
#pragma unroll
    for (int i = 0; i < 38; ++i) uv[i] = u[(t0 + i) * 256 + tid];
    __builtin_amdgcn_sched_barrier(0);
    float a[8];
#pragma unroll
    for (int j = 0; j < 8; ++j) a[j] = cb;
#pragma unroll
    for (int k = 0; k < 31; ++k)
#pragma unroll
      for (int j = 0; j < 8; ++j) a[j] += w[k] * uv[j + k];
#pragma unroll
    for (int j = 0; j < 8; ++j) u[(t0 + j) * 256 + tid] = a[j];
  }
  __syncthreads();
  u16* MIX = (u16*)(p.ws + OFF_H);
  const float4 lw = *(const float4*)(p.ln_a_w + l * 256 + lane * 4);
  const float4 lb = *(const float4*)(p.ln_a_b + l * 256 + lane * 4);
  uint2 zzv[8];
#pragma unroll
  for (int tt = 0; tt < 8; ++tt) zzv[tt] = *(const uint2*)(P + (size_t)(g0 + wave * 8 + tt) * PS + C_ZA + lane * 4);
#pragma unroll
  for (int tt = 0; tt < 8; ++tt) {
    int t = wave * 8 + tt;
    float4 v = *(const float4*)(u + t * 256 + lane * 4);
    float mean = wsum(v.x + v.y + v.z + v.w, lane) * (1.f / 256.f);
    float d0 = v.x - mean, d1 = v.y - mean, d2 = v.z - mean, d3 = v.w - mean;
    float var = wsum(d0 * d0 + d1 * d1 + d2 * d2 + d3 * d3, lane) * (1.f / 256.f);
    float rs = rsqrtf(var + 1e-6f);
    size_t row = (size_t)(g0 + t);
    uint2 zz = zzv[tt];
    float z0 = bf2f((u16)(zz.x & 0xffff)), z1 = bf2f((u16)(zz.x >> 16)), z2 = bf2f((u16)(zz.y & 0xffff)),
          z3 = bf2f((u16)(zz.y >> 16));
    float o0 = siluf_(d0 * rs * lw.x + lb.x) * siluf_(z0);
    float o1 = siluf_(d1 * rs * lw.y + lb.y) * siluf_(z1);
    float o2 = siluf_(d2 * rs * lw.z + lb.z) * siluf_(z2);
    float o3 = siluf_(d3 * rs * lw.w + lb.w) * siluf_(z3);
    *(uint2*)(MIX + row * 1024 + lane * 4) = make_uint2(pack2(o0, o1), pack2(o2, o3));
  }
}

__device__ void attn_item(const Params& p, int l, int item, char* smem, int wv) {
  const int tid = opaque_tid(wv), lane = tid & 63, wave = tid >> 6, fr = lane & 15, fq = lane >> 4;
  u16* Ks = (u16*)smem;
  u16* Vt = Ks + 64 * 72;
  const u16* P = (const u16*)(p.ws + OFF_P);
  bool latent;
  int b, qb, head;
  if (item < 3072) { latent = true; b = item / 192; qb = (item / 6) % 32; head = item % 6; }
  else { int it = item - 3072; latent = false; b = it / 12; qb = (it / 6) % 2; head = it % 6; }
  const int kvh = head / 3;
  const size_t qrow0 = (latent ? (size_t)b * 4096 : (size_t)NL + b * 256) + qb * 128 + wave * 32;
  bf16x8 qf[2][2];
#pragma unroll
  for (int qt = 0; qt < 2; ++qt)
#pragma unroll
    for (int ds = 0; ds < 2; ++ds)
      qf[qt][ds] = *(const bf16x8*)(P + (qrow0 + qt * 16 + fr) * PS + C_QC + head * 64 + ds * 32 + fq * 8);
  const float sinkv = p.sink[l * 6 + head] * 1.44269504088896f;
  float mrow[2] = {sinkv, sinkv};
  float lp[2];
  lp[0] = lp[1] = (fq == 0) ? 1.f : 0.f;
  f32x4 o[2][4];
#pragma unroll
  for (int qt = 0; qt < 2; ++qt)
#pragma unroll
    for (int dt = 0; dt < 4; ++dt) o[qt][dt] = (f32x4){0.f, 0.f, 0.f, 0.f};
  const int tlo = latent ? (qb == 0 ? 2 : 0) : 0;
  const int thi = latent ? min(6, 66 - 2 * qb) : 0;
  const int nl = thi - tlo;
  const int ntile = nl + 4;
  const int qw0 = qb * 128 + wave * 32;
  char* stg = (char*)(Vt + 64 * 72);
  auto tile_row0 = [&](int si, bool& local, int& kb0) -> size_t {
    local = si < nl;
    kb0 = local ? qb * 128 - 128 + (tlo + si) * 64 : (si - nl) * 64;
    return local ? (size_t)b * 4096 + kb0 : (size_t)NL + b * 256 + kb0;
  };
  auto prefetch = [&](int si) {
    bool lc; int k0;
    size_t krow0 = tile_row0(si, lc, k0);
#pragma unroll
    for (int rep = 0; rep < 2; ++rep) {
      int idx = tid + rep * 256;
      int key = idx >> 3, s8 = idx & 7;
      glds16(P + (krow0 + key) * PS + C_KC + kvh * 64 + s8 * 8, stg + idx * 16);
      glds16(P + (krow0 + key) * PS + C_VC + kvh * 64 + s8 * 8, stg + 8192 + idx * 16);
    }
  };
  __syncthreads();
  prefetch(0);
  for (int si = 0; si < ntile; ++si) {
    bool local; int kb0;
    tile_row0(si, local, kb0);
    asm volatile("s_waitcnt vmcnt(0)" ::: "memory");
    __syncthreads();
#pragma unroll
    for (int rep = 0; rep < 2; ++rep) {
      int idx = tid + rep * 256;
      int key = idx >> 3, s8 = idx & 7;
      uint4 kv = *(const uint4*)(stg + idx * 16);
      uint4 vv = *(const uint4*)(stg + 8192 + idx * 16);
      *(uint4*)(Ks + key * 72 + s8 * 8) = kv;
      unsigned vw[4] = {vv.x, vv.y, vv.z, vv.w};
#pragma unroll
      for (int e = 0; e < 4; ++e) {
        Vt[(s8 * 8 + 2 * e) * 72 + key] = (u16)(vw[e] & 0xffff);
        Vt[(s8 * 8 + 2 * e + 1) * 72 + key] = (u16)(vw[e] >> 16);
      }
    }
    __syncthreads();
    if (local && (kb0 + 63 < qw0 - 128 || kb0 > qw0 + 31 + 128)) {
      if (si + 1 < ntile) prefetch(si + 1);
      continue;
    }
    bf16x8 kf[4][2];
#pragma unroll
    for (int kt = 0; kt < 4; ++kt)
#pragma unroll
      for (int ds = 0; ds < 2; ++ds) kf[kt][ds] = *(const bf16x8*)(Ks + (kt * 16 + fr) * 72 + ds * 32 + fq * 8);
    bf16x8 vf[4][2];
#pragma unroll
    for (int dt = 0; dt < 4; ++dt)
#pragma unroll
      for (int k2 = 0; k2 < 2; ++k2) {
        uint2 a = *(const uint2*)(Vt + (dt * 16 + fr) * 72 + k2 * 32 + fq * 4);
        uint2 c = *(const uint2*)(Vt + (dt * 16 + fr) * 72 + k2 * 32 + 16 + fq * 4);
        union { uint4 u; bf16x8 v; } cv;
        cv.u = make_uint4(a.x, a.y, c.x, c.y);
        vf[dt][k2] = cv.v;
      }
    __builtin_amdgcn_sched_barrier(0);
    if (si + 1 < ntile) prefetch(si + 1);
    __builtin_amdgcn_sched_barrier(0);
#pragma unroll
    for (int qt = 0; qt < 2; ++qt) {
      f32x4 s[4];
#pragma unroll
      for (int kt = 0; kt < 4; ++kt) {
        s[kt] = (f32x4){0.f, 0.f, 0.f, 0.f};
#pragma unroll
        for (int ds = 0; ds < 2; ++ds) s[kt] = mfma16(kf[kt][ds], qf[qt][ds], s[kt]);
      }
      if (local && !(kb0 >= qw0 + 31 - 128 && kb0 + 63 <= qw0 + 128)) {
        int qpos = qw0 + qt * 16 + fr;
#pragma unroll
        for (int kt = 0; kt < 4; ++kt)
#pragma unroll
          for (int j = 0; j < 4; ++j) {
            int kpos = kb0 + kt * 16 + fq * 4 + j;
            int d = kpos - qpos;
            if (d > 128 || d < -128) s[kt][j] = -INFINITY;
          }
      }
      float mx = -INFINITY;
#pragma unroll
      for (int kt = 0; kt < 4; ++kt)
#pragma unroll
        for (int j = 0; j < 4; ++j) mx = fmaxf(mx, s[kt][j]);
      mx = fmaxf(mx, shx(mx, 16, lane));
      mx = fmaxf(mx, shx(mx, 32, lane));
      float mnew = fmaxf(mrow[qt], mx);
      float alpha = __builtin_amdgcn_exp2f(mrow[qt] - mnew);
      mrow[qt] = mnew;
      float psum = 0.f;
#pragma unroll
      for (int kt = 0; kt < 4; ++kt)
#pragma unroll
        for (int j = 0; j < 4; ++j) {
          float pv = __builtin_amdgcn_exp2f(s[kt][j] - mnew);
          s[kt][j] = pv;
          psum += pv;
        }
      lp[qt] = lp[qt] * alpha + psum;
#pragma unroll
      for (int dt = 0; dt < 4; ++dt) {
        o[qt][dt][0] *= alpha; o[qt][dt][1] *= alpha; o[qt][dt][2] *= alpha; o[qt][dt][3] *= alpha;
      }
#pragma unroll
      for (int k2 = 0; k2 < 2; ++k2) {
        union { uint4 u; bf16x8 v; } pf;
        pf.u = make_uint4(pack2(s[2 * k2][0], s[2 * k2][1]), pack2(s[2 * k2][2], s[2 * k2][3]),
                          pack2(s[2 * k2 + 1][0], s[2 * k2 + 1][1]), pack2(s[2 * k2 + 1][2], s[2 * k2 + 1][3]));
#pragma unroll
        for (int dt = 0; dt < 4; ++dt) o[qt][dt] = mfma16(vf[dt][k2], pf.v, o[qt][dt]);
      }
    }
  }
  u16* MIX = (u16*)(p.ws + OFF_H);
#pragma unroll
  for (int qt = 0; qt < 2; ++qt) {
    float lt = lp[qt];
    lt += shx(lt, 16, lane);
    lt += shx(lt, 32, lane);
    float inv = 1.f / lt;
    size_t row = qrow0 + qt * 16 + fr;
#pragma unroll
    for (int dt = 0; dt < 4; ++dt) {
      int d = dt * 16 + fq * 4;
      uint2 zz = *(const uint2*)(P + row * PS + C_ZC + head * 64 + d);
      float z0 = bf2f((u16)(zz.x & 0xffff)), z1 = bf2f((u16)(zz.x >> 16)), z2 = bf2f((u16)(zz.y & 0xffff)),
            z3 = bf2f((u16)(zz.y >> 16));
      float o0 = o[qt][dt][0] * inv * siluf_(z0);
      float o1 = o[qt][dt][1] * inv * siluf_(z1);
      float o2 = o[qt][dt][2] * inv * siluf_(z2);
      float o3 = o[qt][dt][3] * inv * siluf_(z3);
      *(uint2*)(MIX + row * 1024 + 640 + head * 64 + d) = make_uint2(pack2(o0, o1), pack2(o2, o3));
    }
  }
}

__device__ __forceinline__ void mm64(const u16* A, const u16* Bt, int wave, int fr, int fq, f32x4 acc[4]) {
#pragma unroll
  for (int kk = 0; kk < 2; ++kk) {
    bf16x8 a = *(const bf16x8*)(A + (16 * wave + fr) * 72 + kk * 32 + fq * 8);
#pragma unroll
    for (int n = 0; n < 4; ++n) {
      bf16x8 bb = *(const bf16x8*)(Bt + (n * 16 + fr) * 72 + kk * 32 + fq * 8);
      acc[n] = mfma16(a, bb, acc[n]);
    }
  }
}

__device__ __forceinline__ f32x4 mfma4f(float a, float b, f32x4 c) {
  return __builtin_amdgcn_mfma_f32_16x16x4f32(a, b, c, 0, 0, 0);
}

__device__ __forceinline__ void lds_barrier() {
  asm volatile("s_waitcnt lgkmcnt(0)" ::: "memory");
  __builtin_amdgcn_s_barrier();
  asm volatile("" ::: "memory");
}

__device__ void dn_item(const Params& p, int l, int item, char* smem, int wv) {
  const int tid = opaque_tid(wv), lane = tid & 63, wave = tid >> 6, fr = lane & 15, fq = lane >> 4;
  const int b = item / 12, h = (item / 2) % 6, dir = item & 1;
  constexpr int RS = 200;
  constexpr int XS = 68;
  u16* R0 = (u16*)smem;
  float* LfT = (float*)smem;
  u16* Ib = (u16*)(smem + 17408);
  u16* VnT = (u16*)smem;
  u16* Kb = (u16*)(smem + 27200);
  u16* Vb = Kb + 4608;
  u16* Qb = Vb + 4608;
  float* X = (float*)(smem + 27200);
  u16* KdT = (u16*)(smem + 27200 + 27648);
  u16* Stb = KdT + 4608;
  float* gcs = (float*)(smem + 73280);
  float* bts = gcs + 64;
  float* Tinv = (float*)(smem + 73792);
  float* cw = (float*)(smem + 77888);
  const u16* P = (const u16*)(p.ws + OFF_P);
  const float* SC = (const float*)(p.ws + OFF_SC);
  u16* Obuf = (u16*)(p.ws + (dir ? OFF_OB : OFF_OF));
  const float aexp = expf(p.a_log[l * 12 + dir * 6 + h]);
  const float dtb = p.dt_bias[l * 12 + dir * 6 + h];
  f32x4 S[4];
#pragma unroll
  for (int n = 0; n < 4; ++n) S[n] = (f32x4){0.f, 0.f, 0.f, 0.f};
  __syncthreads();
  for (int i = tid; i < 64 * 72; i += 256) Stb[i] = 0;
  for (int i = tid; i < 960; i += 256) {
    int k = i / 192, c = i % 192, part = c >> 6, d = c & 63;
    cw[i] = p.qkv_conv_w[((size_t)l * 5 + k) * 1152 + part * 384 + h * 64 + d];
  }
  uint4 pre[7];
  float scb = 0.f, scg = 0.f;
  auto chunk_info = [&](int step, size_t& gbase, int& tb, int& Ls) {
    const bool isctx = step < 4;
    const int ci = isctx ? step : step - 4;
    const int nch = isctx ? 4 : 64;
    const int chunk = dir ? nch - 1 - ci : ci;
    Ls = isctx ? 256 : 4096;
    gbase = isctx ? (size_t)NL + b * 256 : (size_t)b * 4096;
    tb = chunk * 64;
  };
  auto prefetch = [&](int step) {
    size_t gbase; int tb, Ls;
    chunk_info(step, gbase, tb, Ls);
    int tl = tid;
    asm volatile("" : "+v"(tl));
    const int rr = tl / 24, seg = tl - rr * 24, part = seg >> 3, s8 = seg & 7;
    const u16* src = P + (gbase + tb - 2 + rr) * PS + C_QB + part * 384 + h * 64 + s8 * 8;
#pragma unroll
    for (int q = 0; q < 7; ++q) {
      int r = rr + 10 * q;
      int t = tb - 2 + r;
      uint4 val = make_uint4(0, 0, 0, 0);
      if (tl < 240 && r < 68 && t >= 0 && t < Ls) val = *(const uint4*)(src + (size_t)(10 * q) * PS);
      pre[q] = val;
    }
    if (wave == 0) {
      int tok = tb + (dir ? 63 - lane : lane);
      const float* sc = SC + (gbase + tok) * 32 + dir * 12;
      scb = sc[h];
      scg = sc[6 + h];
    }
  };
  auto commit = [&]() {
    int tl = tid;
    asm volatile("" : "+v"(tl));
    const int rr = tl / 24, seg = tl - rr * 24, part = seg >> 3, s8 = seg & 7;
#pragma unroll
    for (int q = 0; q < 7; ++q) {
      int r = rr + 10 * q;
      if (tl < 240 && r < 68) *(uint4*)(R0 + r * RS + part * 64 + s8 * 8) = pre[q];
    }
    if (wave == 0) {
      float bet = sigmoidf_(scb);
      float xx = scg + dtb;
      float ex = __expf(xx);
      float sp = xx > 20.f ? xx : (ex < 0.01f ? ex * (1.f - ex * (0.5f - ex * (1.f / 3.f))) : __logf(1.f + ex));
      float g = -aexp * sp;
#pragma unroll
      for (int off = 1; off < 64; off <<= 1) {
        float tv = shup(g, off, lane);
        if (lane >= off) g += tv;
      }
      gcs[lane] = g;
      bts[lane] = bet;
    }
  };
  prefetch(0);
  commit();
  __syncthreads();

  for (int step = 0; step < 68; ++step) {
    size_t gbase; int tb, Ls;
    chunk_info(step, gbase, tb, Ls);
    const bool need_out = (step >= 4) || (l < 3);
    {
      const int ti = tid >> 2, dc = tid & 3;
      const int ip = dir ? 63 - ti : ti;
      const float ekd = __expf(gcs[63] - gcs[ip]);
#pragma unroll
      for (int part = 0; part < 3; ++part) {
        float acc[16];
#pragma unroll
        for (int e = 0; e < 16; ++e) acc[e] = 0.f;
#pragma unroll
        for (int kb2 = 0; kb2 < 2; ++kb2) {
          const int k0 = kb2 * 3, nk = kb2 ? 2 : 3;
          uint4 rv[3][2];
          float4 wv4[3][4];
#pragma unroll
          for (int kq = 0; kq < 3; ++kq) {
            if (kq < nk) {
              const int kk = k0 + kq;
              const u16* rr = R0 + (ti + kk) * RS + part * 64 + dc * 16;
              rv[kq][0] = *(const uint4*)rr;
              rv[kq][1] = *(const uint4*)(rr + 8);
              const float* wp = cw + kk * 192 + part * 64 + dc * 16;
#pragma unroll
              for (int e4 = 0; e4 < 4; ++e4) wv4[kq][e4] = *(const float4*)(wp + e4 * 4);
            }
          }
          __builtin_amdgcn_sched_barrier(0);
#pragma unroll
          for (int kq = 0; kq < 3; ++kq) {
            if (kq < nk) {
              unsigned rw[8] = {rv[kq][0].x, rv[kq][0].y, rv[kq][0].z, rv[kq][0].w, rv[kq][1].x, rv[kq][1].y, rv[kq][1].z, rv[kq][1].w};
#pragma unroll
              for (int e4 = 0; e4 < 4; ++e4) {
                float4 w = wv4[kq][e4];
                acc[e4 * 4 + 0] += w.x * __uint_as_float(rw[e4 * 2] << 16);
                acc[e4 * 4 + 1] += w.y * __uint_as_float(rw[e4 * 2] & 0xffff0000u);
                acc[e4 * 4 + 2] += w.z * __uint_as_float(rw[e4 * 2 + 1] << 16);
                acc[e4 * 4 + 3] += w.w * __uint_as_float(rw[e4 * 2 + 1] & 0xffff0000u);
              }
            }
          }
          __builtin_amdgcn_sched_barrier(0);
        }
        float ss = 0.f;
#pragma unroll
        for (int e = 0; e < 16; ++e) { acc[e] = siluf_(acc[e]); ss += acc[e] * acc[e]; }
        float sc = 1.f;
        if (part < 2) {
          ss += shx(ss, 1, lane);
          ss += shx(ss, 2, lane);
          sc = rsqrtf(ss + 1e-6f) * (part == 0 ? 0.125f : 1.f);
        }
#pragma unroll
        for (int e = 0; e < 16; ++e) acc[e] *= sc;
        u16* dst = (part == 0 ? Qb : (part == 1 ? Kb : Vb)) + ip * 72 + dc * 16;
        *(uint4*)dst = make_uint4(pack2(acc[0], acc[1]), pack2(acc[2], acc[3]), pack2(acc[4], acc[5]), pack2(acc[6], acc[7]));
        *(uint4*)(dst + 8) = make_uint4(pack2(acc[8], acc[9]), pack2(acc[10], acc[11]), pack2(acc[12], acc[13]), pack2(acc[14], acc[15]));
        if (part == 1) {
#pragma unroll
          for (int e = 0; e < 16; ++e) KdT[(dc * 16 + e) * 72 + ip] = f2bf(acc[e] * ekd);
        }
      }
    }
    lds_barrier();
    if (step + 1 < 68) prefetch(step + 1);
    f32x4 rhs[4];
    {
      const int i0 = 16 * wave + fq * 4;
      bf16x8 ka[2], qa[2], kbt[2][4];
      float gi[4], bi[4], gj[4];
      u16 vraw[4][4];
#pragma unroll
      for (int kk = 0; kk < 2; ++kk) {
        ka[kk] = *(const bf16x8*)(Kb + (16 * wave + fr) * 72 + kk * 32 + fq * 8);
        qa[kk] = *(const bf16x8*)(Qb + (16 * wave + fr) * 72 + kk * 32 + fq * 8);
#pragma unroll
        for (int n = 0; n < 4; ++n) kbt[kk][n] = *(const bf16x8*)(Kb + (n * 16 + fr) * 72 + kk * 32 + fq * 8);
      }
      __builtin_amdgcn_sched_barrier(0);
      f32x4 kk4[4], qk[4];
#pragma unroll
      for (int n = 0; n < 4; ++n) {
        kk4[n] = (f32x4){0.f, 0.f, 0.f, 0.f};
        qk[n] = (f32x4){0.f, 0.f, 0.f, 0.f};
        rhs[n] = (f32x4){0.f, 0.f, 0.f, 0.f};
      }
#pragma unroll
      for (int kk = 0; kk < 2; ++kk)
#pragma unroll
        for (int n = 0; n < 4; ++n) {
          kk4[n] = mfma16(ka[kk], kbt[kk][n], kk4[n]);
          qk[n] = mfma16(qa[kk], kbt[kk][n], qk[n]);
        }
      __builtin_amdgcn_sched_barrier(0);
      {
        bf16x8 sbt[2][4];
#pragma unroll
        for (int kk = 0; kk < 2; ++kk)
#pragma unroll
          for (int n = 0; n < 4; ++n) sbt[kk][n] = *(const bf16x8*)(Stb + (n * 16 + fr) * 72 + kk * 32 + fq * 8);
#pragma unroll
        for (int j = 0; j < 4; ++j) { gi[j] = gcs[i0 + j]; bi[j] = bts[i0 + j]; gj[j] = gcs[j * 16 + fr]; }
#pragma unroll
        for (int n = 0; n < 4; ++n)
#pragma unroll
          for (int j = 0; j < 4; ++j) vraw[n][j] = Vb[(i0 + j) * 72 + n * 16 + fr];
        __builtin_amdgcn_sched_barrier(0);
#pragma unroll
        for (int kk = 0; kk < 2; ++kk)
#pragma unroll
          for (int n = 0; n < 4; ++n) rhs[n] = mfma16(ka[kk], sbt[kk][n], rhs[n]);
      }
      float eg[4];
#pragma unroll
      for (int j = 0; j < 4; ++j) eg[j] = __expf(gi[j]);
#pragma unroll
      for (int n = 0; n < 4; ++n) {
        const int jj = n * 16 + fr;
        float lv[4];
#pragma unroll
        for (int j = 0; j < 4; ++j) {
          int i = i0 + j;
          float e = (i >= jj) ? __expf(gi[j] - gj[n]) : 0.f;
          lv[j] = (i > jj) ? bi[j] * kk4[n][j] * e : 0.f;
          Ib[i * 72 + jj] = f2bf(qk[n][j] * e);
          rhs[n][j] = bi[j] * (bf2f(vraw[n][j]) - eg[j] * rhs[n][j]);
        }
        *(float4*)(LfT + jj * 68 + i0) = make_float4(lv[0], lv[1], lv[2], lv[3]);
      }
    }
    lds_barrier();
#pragma unroll
    for (int n = 0; n < 4; ++n)
#pragma unroll
      for (int j = 0; j < 4; ++j) X[(16 * wave + fq * 4 + j) * XS + n * 16 + fr] = rhs[n][j];
    {
      const int c = lane & 15;
      const float* ld = LfT + (16 * wave) * 68 + 16 * wave;
      float x[16];
#pragma unroll
      for (int i = 0; i < 16; ++i) x[i] = (i == c) ? 1.f : 0.f;
#pragma unroll
      for (int hb = 0; hb < 2; ++hb) {
        const int j0 = hb ? 7 : 0, j1 = hb ? 15 : 7;
        float4 lr[8][4];
#pragma unroll
        for (int jq = 0; jq < 8; ++jq) {
          const int j = j0 + jq;
          if (j < j1) {
#pragma unroll
            for (int q4 = 0; q4 < 4; ++q4)
              if (q4 * 4 + 3 > j) lr[jq][q4] = *(const float4*)(ld + j * 68 + q4 * 4);
          }
        }
        __builtin_amdgcn_sched_barrier(0);
#pragma unroll
        for (int jq = 0; jq < 8; ++jq) {
          const int j = j0 + jq;
          if (j < j1) {
            const float xj = x[j];
#pragma unroll
            for (int q4 = 0; q4 < 4; ++q4) {
              if (q4 * 4 + 3 > j) {
                float4 lq = lr[jq][q4];
                if (q4 * 4 + 0 > j) x[q4 * 4 + 0] -= lq.x * xj;
                if (q4 * 4 + 1 > j) x[q4 * 4 + 1] -= lq.y * xj;
                if (q4 * 4 + 2 > j) x[q4 * 4 + 2] -= lq.z * xj;
                if (q4 * 4 + 3 > j) x[q4 * 4 + 3] -= lq.w * xj;
              }
            }
          }
        }
        __builtin_amdgcn_sched_barrier(0);
      }
      if (lane < 16) {
#pragma unroll
        for (int i = 0; i < 16; ++i) Tinv[(wave * 16 + i) * 16 + c] = x[i];
      }
    }
    lds_barrier();
    {
      float* Xw = X + 16 * wave + fr;
      float la[6][4], ta[4][4];
      {
        int bi6 = 0;
#pragma unroll
        for (int r = 1; r < 4; ++r)
#pragma unroll
          for (int c = 0; c < 3; ++c)
            if (c < r) {
#pragma unroll
              for (int k4 = 0; k4 < 4; ++k4) la[bi6][k4] = -LfT[(16 * c + 4 * k4 + fq) * 68 + 16 * r + fr];
              ++bi6;
            }
#pragma unroll
        for (int r = 0; r < 4; ++r)
#pragma unroll
          for (int k4 = 0; k4 < 4; ++k4) ta[r][k4] = Tinv[(r * 16 + fr) * 16 + 4 * k4 + fq];
      }
      int bidx = 0;
#pragma unroll
      for (int r = 0; r < 4; ++r) {
        f32x4 acc;
        float bv[3][4];
#pragma unroll
        for (int j = 0; j < 4; ++j) acc[j] = Xw[(16 * r + fq * 4 + j) * XS];
#pragma unroll
        for (int c = 0; c < 3; ++c)
          if (c < r) {
#pragma unroll
            for (int k4 = 0; k4 < 4; ++k4) bv[c][k4] = Xw[(16 * c + 4 * k4 + fq) * XS];
          }
        __builtin_amdgcn_sched_barrier(0);
#pragma unroll
        for (int c = 0; c < 3; ++c)
          if (c < r) {
#pragma unroll
            for (int k4 = 0; k4 < 4; ++k4) acc = mfma4f(la[bidx][k4], bv[c][k4], acc);
            ++bidx;
          }
#pragma unroll
        for (int j = 0; j < 4; ++j) Xw[(16 * r + fq * 4 + j) * XS] = acc[j];
        float bd[4];
#pragma unroll
        for (int k4 = 0; k4 < 4; ++k4) bd[k4] = Xw[(16 * r + 4 * k4 + fq) * XS];
        f32x4 xr = (f32x4){0.f, 0.f, 0.f, 0.f};
#pragma unroll
        for (int k4 = 0; k4 < 4; ++k4) xr = mfma4f(ta[r][k4], bd[k4], xr);
#pragma unroll
        for (int j = 0; j < 4; ++j) Xw[(16 * r + fq * 4 + j) * XS] = xr[j];
      }
    }
    lds_barrier();
    {
      const int v = tid & 63, ib = (tid >> 6) * 16;
      float xv[16];
#pragma unroll
      for (int ii = 0; ii < 16; ++ii) xv[ii] = X[(ib + ii) * XS + v];
      __builtin_amdgcn_sched_barrier(0);
#pragma unroll
      for (int ii = 0; ii < 16; ii += 2) *(unsigned*)(VnT + v * 72 + ib + ii) = pack2(xv[ii], xv[ii + 1]);
    }
    lds_barrier();
    {
      float ge[4];
#pragma unroll
      for (int j = 0; j < 4; ++j) ge[j] = gcs[16 * wave + fq * 4 + j];
      const float glast = gcs[63];
      if (need_out) {
        f32x4 oo[4];
#pragma unroll
        for (int n = 0; n < 4; ++n) oo[n] = (f32x4){0.f, 0.f, 0.f, 0.f};
        {
          bf16x8 qa[2], sbt[2][4];
#pragma unroll
          for (int kk = 0; kk < 2; ++kk) {
            qa[kk] = *(const bf16x8*)(Qb + (16 * wave + fr) * 72 + kk * 32 + fq * 8);
#pragma unroll
            for (int n = 0; n < 4; ++n) sbt[kk][n] = *(const bf16x8*)(Stb + (n * 16 + fr) * 72 + kk * 32 + fq * 8);
          }
          __builtin_amdgcn_sched_barrier(0);
#pragma unroll
          for (int kk = 0; kk < 2; ++kk)
#pragma unroll
            for (int n = 0; n < 4; ++n) oo[n] = mfma16(qa[kk], sbt[kk][n], oo[n]);
        }
        __builtin_amdgcn_sched_barrier(0);
        {
          bf16x8 ia[2], vbt[2][4];
#pragma unroll
          for (int kk = 0; kk < 2; ++kk) {
            ia[kk] = *(const bf16x8*)(Ib + (16 * wave + fr) * 72 + kk * 32 + fq * 8);
#pragma unroll
            for (int n = 0; n < 4; ++n) vbt[kk][n] = *(const bf16x8*)(VnT + (n * 16 + fr) * 72 + kk * 32 + fq * 8);
          }
          __builtin_amdgcn_sched_barrier(0);
#pragma unroll
          for (int j = 0; j < 4; ++j) {
            float e = __expf(ge[j]);
#pragma unroll
            for (int n = 0; n < 4; ++n) oo[n][j] *= e;
          }
#pragma unroll
          for (int kk = 0; kk < 2; ++kk)
#pragma unroll
            for (int n = 0; n < 4; ++n) oo[n] = mfma16(ia[kk], vbt[kk][n], oo[n]);
        }
#pragma unroll
        for (int n = 0; n < 4; ++n)
#pragma unroll
          for (int j = 0; j < 4; ++j) {
            int i = 16 * wave + fq * 4 + j;
            int tok = tb + (dir ? 63 - i : i);
            Obuf[(gbase + tok) * 384 + h * 64 + n * 16 + fr] = f2bf(oo[n][j]);
          }
        __builtin_amdgcn_sched_barrier(0);
      }
      f32x4 dS[4];
#pragma unroll
      for (int n = 0; n < 4; ++n) dS[n] = (f32x4){0.f, 0.f, 0.f, 0.f};
      {
        bf16x8 va[2], kdt[2][4];
#pragma unroll
        for (int kk = 0; kk < 2; ++kk) {
          va[kk] = *(const bf16x8*)(VnT + (16 * wave + fr) * 72 + kk * 32 + fq * 8);
#pragma unroll
          for (int n = 0; n < 4; ++n) kdt[kk][n] = *(const bf16x8*)(KdT + (n * 16 + fr) * 72 + kk * 32 + fq * 8);
        }
        __builtin_amdgcn_sched_barrier(0);
#pragma unroll
        for (int kk = 0; kk < 2; ++kk)
#pragma unroll
          for (int n = 0; n < 4; ++n) dS[n] = mfma16(va[kk], kdt[kk][n], dS[n]);
      }
      const float dec = __expf(glast);
#pragma unroll
      for (int n = 0; n < 4; ++n)
#pragma unroll
        for (int j = 0; j < 4; ++j) S[n][j] = S[n][j] * dec + dS[n][j];
    }
    lds_barrier();
#pragma unroll
    for (int n = 0; n < 4; ++n)
#pragma unroll
      for (int j = 0; j < 4; ++j) Stb[(16 * wave + fq * 4 + j) * 72 + n * 16 + fr] = f2bf(S[n][j]);
    if (step + 1 < 68) commit();
    lds_barrier();
  }
}

__device__ void phase_mix(const Params& p, int l, char* smem, int* s_item, int cslot, int mask, int wv) {
  int* cnt = (int*)(p.ws + OFF_CNT) + cslot;
  const int n_dn = 192;
  const int n_attn = 3072 + (l < 3 ? 192 : 0);
  const int n_conv = l < 3 ? 2176 : 2048;
  const int total = n_attn + n_conv;
  if ((mask & 1) && (int)blockIdx.x < n_dn) dn_item(p, l, blockIdx.x, smem, wv);
  for (;;) {
    __syncthreads();
    if (opaque_tid(wv) == 0) *s_item = atomicAdd(cnt, 1);
    __syncthreads();
    const int item = *s_item;
    if (item >= total) break;
    if (item < n_attn) { if (mask & 2) attn_item(p, l, item, smem, wv); }
    else { if (mask & 4) conv_item(p, l, item - n_attn, smem, wv); }
  }
}

__device__ void phase_bnorm(const Params& p, int l, int wv) {
  const int tid = opaque_tid(wv);
  const int ntok = l < 3 ? NT : NL;
  const u16* OF = (const u16*)(p.ws + OFF_OF);
  const u16* OB = (const u16*)(p.ws + OFF_OB);
  const u16* P = (const u16*)(p.ws + OFF_P);
  u16* MIX = (u16*)(p.ws + OFF_H);
  const int sub = tid & 15, lane = tid & 63;
  const float4 w = *(const float4*)(p.dn_norm_w + l * 64 + sub * 4);
  const int ngroups = ntok * 6;
  const int gstride = gridDim.x * 16;
  for (int g0 = (blockIdx.x * 256 + tid) >> 4; g0 < ngroups; g0 += gstride * 4) {
    uint2 av[4], bv[4];
    uint2 zv[4];
#pragma unroll
    for (int k = 0; k < 4; ++k) {
      int gidx = g0 + k * gstride;
      if (gidx < ngroups) {
        int tok = gidx / 6, h = gidx % 6;
        av[k] = ld_nt8(OF + (size_t)tok * 384 + h * 64 + sub * 4);
        bv[k] = ld_nt8(OB + (size_t)tok * 384 + h * 64 + sub * 4);
        zv[k] = *(const uint2*)(P + (size_t)tok * PS + C_ZB + h * 64 + sub * 4);
      } else {
        av[k] = make_uint2(0, 0); bv[k] = av[k]; zv[k] = make_uint2(0, 0);
      }
    }
#pragma unroll
    for (int k = 0; k < 4; ++k) {
      int gidx = g0 + k * gstride;
      float o0 = __uint_as_float(av[k].x << 16) + __uint_as_float(bv[k].x << 16);
      float o1 = __uint_as_float(av[k].x & 0xffff0000u) + __uint_as_float(bv[k].x & 0xffff0000u);
      float o2 = __uint_as_float(av[k].y << 16) + __uint_as_float(bv[k].y << 16);
      float o3 = __uint_as_float(av[k].y & 0xffff0000u) + __uint_as_float(bv[k].y & 0xffff0000u);
      float ss = o0 * o0 + o1 * o1 + o2 * o2 + o3 * o3;
      ss += shx(ss, 1, lane); ss += shx(ss, 2, lane); ss += shx(ss, 4, lane); ss += shx(ss, 8, lane);
      float r = rsqrtf(ss * (1.f / 64.f) + 1e-6f);
      uint2 zz = zv[k];
      float z0 = bf2f((u16)(zz.x & 0xffff)), z1 = bf2f((u16)(zz.x >> 16)), z2 = bf2f((u16)(zz.y & 0xffff)),
            z3 = bf2f((u16)(zz.y >> 16));
      float y0 = o0 * r * w.x * siluf_(z0), y1 = o1 * r * w.y * siluf_(z1), y2 = o2 * r * w.z * siluf_(z2),
            y3 = o3 * r * w.w * siluf_(z3);
      if (gidx < ngroups) {
        int tok = gidx / 6, h = gidx % 6;
        *(uint2*)(MIX + (size_t)tok * 1024 + 256 + h * 64 + sub * 4) = make_uint2(pack2(y0, y1), pack2(y2, y3));
      }
    }
  }
}

__device__ void phase_final(const Params& p, int wv) {
  const int tid = opaque_tid(wv), lane = tid & 63, wave = tid >> 6;
  for (int g = blockIdx.x * 4 + wave; g < NL / 4; g += gridDim.x * 4) {
    float* xr = p.out + (size_t)g * 4 * 1024;
    float4 v[4][4];
#pragma unroll
    for (int rr = 0; rr < 4; ++rr)
#pragma unroll
      for (int i = 0; i < 4; ++i) v[rr][i] = ld_nt16(xr + (size_t)rr * 1024 + (lane + 64 * i) * 4);
    float ss[4];
#pragma unroll
    for (int rr = 0; rr < 4; ++rr) {
      ss[rr] = 0.f;
#pragma unroll
      for (int i = 0; i < 4; ++i)
        ss[rr] += v[rr][i].x * v[rr][i].x + v[rr][i].y * v[rr][i].y + v[rr][i].z * v[rr][i].z + v[rr][i].w * v[rr][i].w;
    }
#pragma unroll
    for (int o = 32; o > 0; o >>= 1) {
#pragma unroll
      for (int rr = 0; rr < 4; ++rr) ss[rr] += shx(ss[rr], o, lane);
    }
#pragma unroll
    for (int i = 0; i < 4; ++i) {
      int c = (lane + 64 * i) * 4;
      float4 w = *(const float4*)(p.final_norm_w + c);
#pragma unroll
      for (int rr = 0; rr < 4; ++rr) {
        float r = rsqrtf(ss[rr] * (1.f / 1024.f) + 1e-6f);
        st_nt16(xr + (size_t)rr * 1024 + c, v[rr][i].x * r * w.x, v[rr][i].y * r * w.y, v[rr][i].z * r * w.z, v[rr][i].w * r * w.w);
      }
    }
  }
}

#define XB_TMO      128
#define XB_XCNT(j)  (256  + 64 * (j))
#define XB_XSUB(j)  (1280 + 64 * (j))
#define XB_XGEN(j)  (2304 + 64 * (j))
#define XB_TOP      3328
#define XB_TOPGEN   3392
#define XCD_BAR_WORDS 3456
#define XB_SPIN_CAP (1u << 18)
#define LAS __attribute__((address_space(3)))
__device__ __forceinline__ unsigned xb_ld(unsigned* p) { return __hip_atomic_load(p, __ATOMIC_RELAXED, __HIP_MEMORY_SCOPE_AGENT); }
__device__ __forceinline__ unsigned xb_add(unsigned* p, unsigned v) { return __hip_atomic_fetch_add(p, v, __ATOMIC_RELAXED, __HIP_MEMORY_SCOPE_AGENT); }
__device__ __forceinline__ unsigned xb_xcc_id() { return (unsigned)__builtin_amdgcn_s_getreg((3 << 11) | 20) & 0xFu; }
#define XB_SPIN(cond, bar) do { unsigned _sp = 0; while (cond) { __builtin_amdgcn_s_sleep(1); \
    if ((++_sp & 255u) == 0u) { if (xb_ld(&(bar)[XB_TMO])) break; if (_sp > XB_SPIN_CAP) { atomicAdd(&(bar)[XB_TMO], 1u); break; } } } } while (0)
struct XcdBarrier { unsigned* bar; unsigned x; volatile LAS unsigned* st; };
__device__ __forceinline__ XcdBarrier xcd_barrier_post(unsigned* bar, volatile LAS unsigned* st, bool t0) {
  XcdBarrier b; b.bar = bar; b.x = xb_xcc_id(); b.st = st;
  if (t0) (void)xb_add(&bar[XB_XCNT(b.x)], 1u);
  return b;
}
__device__ __forceinline__ void xcd_barrier_complete(unsigned* bar, unsigned x, unsigned& nloc, unsigned& nx) {
  const unsigned G = gridDim.x * gridDim.y * gridDim.z;
  unsigned sum, cnt, mine, sp = 0u;
  for (;;) {
    sum = 0u; cnt = 0u; mine = 0u;
#pragma unroll
    for (unsigned j = 0; j < 16; ++j) { const unsigned c = xb_ld(&bar[XB_XCNT(j)]); sum += c; cnt += (c > 0u) ? 1u : 0u; mine = (j == x) ? c : mine; }
    if (sum == G) break;
    __builtin_amdgcn_s_sleep(1);
    if ((++sp & 255u) == 0u) { if (xb_ld(&bar[XB_TMO])) break; if (sp > XB_SPIN_CAP) { atomicAdd(&bar[XB_TMO], 1u); break; } }
  }
  nloc = mine > 0u ? mine : 1u; nx = cnt > 0u ? cnt : 1u;
}
__device__ __forceinline__ void xcd_barrier(const XcdBarrier& b, int wv) {
  asm volatile("s_waitcnt vmcnt(0)" ::: "memory");
  __syncthreads();
  if (opaque_tid(wv) == 0) {
    unsigned* bar = b.bar;
    __builtin_amdgcn_s_waitcnt(0);
    unsigned nloc = b.st[0], nx = b.st[1];
    if (nloc == 0u) { xcd_barrier_complete(bar, b.x, nloc, nx); b.st[0] = nloc; b.st[1] = nx; }
    const unsigned old = xb_add(&bar[XB_XSUB(b.x)], 1u);
    const unsigned gen = old / nloc;
    if (old + 1u == (gen + 1u) * nloc) {
      __builtin_amdgcn_fence(__ATOMIC_RELEASE, "agent");
      asm volatile("s_waitcnt vmcnt(0)" ::: "memory");
      const unsigned og = xb_add(&bar[XB_TOP], 1u);
      const unsigned tg = og / nx;
      if (og + 1u == (tg + 1u) * nx) xb_add(&bar[XB_TOPGEN], 1u);
      else XB_SPIN(xb_ld(&bar[XB_TOPGEN]) == tg, bar);
      __builtin_amdgcn_fence(__ATOMIC_ACQUIRE, "agent");
      xb_add(&bar[XB_XGEN(b.x)], 1u);
      asm volatile("s_waitcnt vmcnt(0)" ::: "memory");
    } else {
      XB_SPIN(xb_ld(&bar[XB_XGEN(b.x)]) == gen, bar);
      __builtin_amdgcn_fence(__ATOMIC_ACQUIRE, "agent");
      asm volatile("s_waitcnt vmcnt(0)" ::: "memory");
    }
  }
  __syncthreads();
}

#define RUNPH(ph) ((ph) >= p.ph_lo && (ph) <= p.ph_hi)
#if MULTI_LAUNCH
#define GSYNC()
#else
#define GSYNC() xcd_barrier(xb, wv)
#endif
__global__ void __launch_bounds__(256, 2) fwd_kernel(Params p) {
  extern __shared__ __attribute__((aligned(16))) char smem[];
  __shared__ uint4 xbw;
  const int wv = __builtin_amdgcn_readfirstlane(threadIdx.x >> 6);
  if (opaque_tid(wv) == 0) xbw = make_uint4(0u, 0u, 0u, 0u);
  __syncthreads();
  int* s_item = (int*)&xbw + 2;
  if (RUNPH(0)) phase_init(p, smem, wv);
#if !MULTI_LAUNCH
  cg::this_grid().sync();
  XcdBarrier xb = xcd_barrier_post((unsigned*)(p.ws + OFF_BAR), (volatile LAS unsigned*)&xbw, opaque_tid(wv) == 0);
#endif
#pragma unroll 1
  for (int l = 0; l < 4; ++l) {
    if (RUNPH(1 + 5 * l)) { phase_norm(p, l, wv); GSYNC(); }
    if (RUNPH(2 + 5 * l)) { phase_gemm<1>(p, l, smem, NT / 256, s_item, wv); GSYNC(); }
    if (RUNPH(3 + 5 * l)) { phase_mix(p, l, smem, s_item, l, 7, wv); GSYNC(); }
    if (RUNPH(4 + 5 * l)) { phase_bnorm(p, l, wv); GSYNC(); }
    if (RUNPH(5 + 5 * l)) { phase_gemm<2>(p, l, smem, (l < 3 ? NT : NL) / 256, s_item, wv); GSYNC(); }
  }
  if (RUNPH(21)) phase_final(p, wv);
}

extern "C" void kernel_launch(void* const* d_in, const int* in_sizes, int n_in, void* d_out, int out_size, void* d_ws,
                              size_t ws_size, hipStream_t stream) {
  static int grid_blocks = 0;
  if (!grid_blocks) {
    int dev = 0, cus = 0, per_cu = 0;
    (void)hipGetDevice(&dev);
    (void)hipDeviceGetAttribute(&cus, hipDeviceAttributeMultiprocessorCount, dev);
    (void)hipFuncSetAttribute((const void*)fwd_kernel, hipFuncAttributeMaxDynamicSharedMemorySize, SMEM_BYTES);
    (void)hipOccupancyMaxActiveBlocksPerMultiprocessor(&per_cu, fwd_kernel, 256, SMEM_BYTES);
    if (per_cu < 1) per_cu = 1;
    grid_blocks = cus * per_cu;
  }
  if (ws_size < WS_END) { fprintf(stderr, "workspace too small: %zu < %zu\n", ws_size, (size_t)WS_END); return; }
  Params p{};
  const float** pp = (const float**)&p;
  for (int i = 0; i < 19; ++i) pp[i] = (const float*)d_in[i];
  p.out = (float*)d_out;
  p.ws = (char*)d_ws;
#if MULTI_LAUNCH
  for (int ph = 0; ph <= 21; ++ph) {
    p.ph_lo = ph; p.ph_hi = ph;
    hipLaunchKernelGGL(fwd_kernel, dim3(grid_blocks), dim3(256), SMEM_BYTES, stream, p);
  }
#else
  p.ph_lo = 0; p.ph_hi = 21;
  void* args[] = {&p};
  hipError_t e = hipLaunchCooperativeKernel((void*)fwd_kernel, dim3(grid_blocks), dim3(256), args, SMEM_BYTES, stream);
  if (e != hipSuccess) fprintf(stderr, "cooperative launch failed: %s (grid %d)\n", hipGetErrorString(e), grid_blocks);
#endif
}
```
